# Optimizing an MI355X kernel written in HIP

```python
import jax, jax.numpy as jnp
from jax import lax
import numpy as np

D_MODEL = 1024
BATCH = 2
SEQ = 8192
DEPTH = 1
DEC_BATCH = 32
DEC_SEQ = 16
PAST_LEN = 1024

CHUNK = 64
LEFT_CHUNKS = 8
HEAD_DIM = 64
H_A = 8
W_A = H_A * HEAD_DIM
REL_CLIP = 128
H_B = 4
DK_B = 64
DV_B = 128
W_BK = H_B * DK_B
W_BV = H_B * DV_B
GATE_RANK = 16
GATE_TAU = 16.0
GLA_BLOCK = 16
N_MEM = 256
H_M = 4
W_M = H_M * HEAD_DIM
EPS = 1e-6
IN_SIZES = (W_A, W_A, W_A, W_A, W_BK, W_BK, W_BV, GATE_RANK, W_BV, W_M, W_M, D_MODEL, D_MODEL, D_MODEL)
D_IN = sum(IN_SIZES)

kernel_name = "hybrid_streaming_encoder_step"


def rms_norm(x, g):
    xf = x.astype(jnp.float32)
    y = xf * lax.rsqrt(jnp.mean(xf * xf, axis=-1, keepdims=True) + EPS)
    return (y * g.astype(jnp.float32)).astype(x.dtype)


def split_heads(z, n):
    return z.reshape(*z.shape[:-1], n, z.shape[-1] // n)


def rel_bias_lookup(table, dist):
    return table[:, jnp.clip(dist, -REL_CLIP, REL_CLIP) + REL_CLIP].astype(jnp.float32)


def band_attention_prompt(q, k, v, table):
    b, t, h, hd = q.shape
    nc = t // CHUNK
    band = (LEFT_CHUNKS + 1) * CHUNK
    qc = q.reshape(b, nc, CHUNK, h, hd)
    pad = ((0, 0), (LEFT_CHUNKS * CHUNK, 0), (0, 0), (0, 0))
    idx = jnp.arange(nc)[:, None] + jnp.arange(LEFT_CHUNKS + 1)[None, :]
    kc = jnp.pad(k, pad).reshape(b, nc + LEFT_CHUNKS, CHUNK, h, hd)[:, idx].reshape(b, nc, band, h, hd)
    vc = jnp.pad(v, pad).reshape(b, nc + LEFT_CHUNKS, CHUNK, h, hd)[:, idx].reshape(b, nc, band, h, hd)
    dist = (LEFT_CHUNKS * CHUNK + jnp.arange(CHUNK))[:, None] - jnp.arange(band)[None, :]
    bias = rel_bias_lookup(table, dist)
    valid = jnp.repeat(idx >= LEFT_CHUNKS, CHUNK, axis=1)
    s = jnp.einsum('bnqhd,bnkhd->bnhqk', qc, kc).astype(jnp.float32) * (hd ** -0.5) + bias[None, None]
    s = jnp.where(valid[None, :, None, None, :], s, -jnp.inf)
    p = jax.nn.softmax(s, axis=-1).astype(v.dtype)
    o = jnp.einsum('bnhqk,bnkhd->bnqhd', p, vc)
    return o.reshape(b, t, h * hd)


def band_attention_step(q, k_new, v_new, k_past, v_past, table):
    b, s_len, h, hd = q.shape
    L = k_past.shape[1]
    kk = jnp.concatenate([k_past, k_new], axis=1)
    vv = jnp.concatenate([v_past, v_new], axis=1)
    dist = (L + jnp.arange(s_len))[:, None] - jnp.arange(L + s_len)[None, :]
    bias = rel_bias_lookup(table, dist)
    s = jnp.einsum('bqhd,bkhd->bhqk', q, kk).astype(jnp.float32) * (hd ** -0.5) + bias[None]
    p = jax.nn.softmax(s, axis=-1).astype(vv.dtype)
    o = jnp.einsum('bhqk,bkhd->bqhd', p, vv)
    return o.reshape(b, s_len, h * hd)


def memory_attention(q, mk, mv):
    b, t, h, hd = q.shape
    s = jnp.einsum('bqhd,bmhd->bhqm', q, mk).astype(jnp.float32) * (hd ** -0.5)
    p = jax.nn.softmax(s, axis=-1).astype(mv.dtype)
    return jnp.einsum('bhqm,bmhd->bqhd', p, mv).reshape(b, t, h * hd)


def gla_scan(q, k, v, log_a, s0):
    b, t, h, _ = q.shape
    pad = (-t) % GLA_BLOCK

    def blocks(z):
        z = jnp.pad(z.astype(jnp.float32), ((0, 0), (0, pad), (0, 0), (0, 0)))
        return z.reshape(b, -1, GLA_BLOCK, h, z.shape[-1]).transpose(1, 0, 3, 2, 4)

    causal = jnp.tril(jnp.ones((GLA_BLOCK, GLA_BLOCK), dtype=bool))

    def step(S, blk):
        qi, ki, vi, ai = blk
        cum = jnp.cumsum(ai, axis=-2)
        last = cum[..., -1:, :]
        diff = jnp.where(causal[:, :, None], cum[..., :, None, :] - cum[..., None, :, :], -jnp.inf)
        att = jnp.einsum('bhtd,bhsd,bhtsd->bhts', qi, ki, jnp.exp(diff))
        o = jnp.einsum('bhts,bhsv->bhtv', att, vi) + jnp.einsum('bhtd,bhdv->bhtv', qi * jnp.exp(cum), S)
        S = S * jnp.exp(last)[..., 0, :, None] + jnp.einsum('bhsd,bhsv->bhdv', ki * jnp.exp(last - cum), vi)
        return S, o

    S, o = lax.scan(step, s0.astype(jnp.float32), (blocks(q), blocks(k), blocks(v), blocks(log_a)))
    o = o.transpose(1, 0, 3, 2, 4).reshape(b, -1, h, v.shape[-1])[:, :t]
    return o.astype(v.dtype), S.astype(s0.dtype)


def memory_kv(mem, g_mem, w_mem_kv, g_km):
    mh = rms_norm(mem, g_mem)
    mk, mv = jnp.split(mh @ w_mem_kv, 2, axis=-1)
    return rms_norm(split_heads(mk, H_M), g_km), split_heads(mv, H_M)


def hybrid_layer(x, attend_a, mem_k, mem_v, s0, norm_in, w_in, g_qa, g_ka, rel_bias,
                 w_gate2, b_gate, g_gla_out, g_qm, w_up_a, w_up_b, w_up_m, w_out):
    b, t, _ = x.shape
    h = rms_norm(x, norm_in)
    proj = h @ w_in
    (qa, ka, va, za, qb, kb, vb, glr, zb, qm, zm, gate_a, gate_b, gate_m) = jnp.split(
        proj, np.cumsum(IN_SIZES)[:-1].tolist(), axis=-1)
    qa = rms_norm(split_heads(qa, H_A), g_qa)
    ka = rms_norm(split_heads(ka, H_A), g_ka)
    va = split_heads(va, H_A)
    out_a = attend_a(qa, ka, va, rel_bias)
    log_a = jax.nn.log_sigmoid((glr @ w_gate2 + b_gate).astype(jnp.float32)) / GATE_TAU
    o_b, s_new = gla_scan(split_heads(qb, H_B) * (DK_B ** -0.5), split_heads(kb, H_B),
                          split_heads(vb, H_B), split_heads(log_a, H_B), s0)
    out_b = rms_norm(o_b, g_gla_out).reshape(b, t, W_BV)
    out_m = memory_attention(rms_norm(split_heads(qm, H_M), g_qm), mem_k, mem_v)
    u = (jax.nn.sigmoid(gate_a) * ((out_a * jax.nn.silu(za)) @ w_up_a)
         + jax.nn.sigmoid(gate_b) * ((out_b * jax.nn.silu(zb)) @ w_up_b)
         + jax.nn.sigmoid(gate_m) * ((out_m * jax.nn.silu(zm)) @ w_up_m))
    return x + u @ w_out, ka, va, s_new


def setup_inputs(seed: int = 0) -> dict:
    key = jax.random.key(seed)
    ks = iter(jax.random.split(key, 32))

    def nrm(shape, scale):
        return jax.random.normal(next(ks), shape, jnp.float32) * scale

    a_keep = min(LEFT_CHUNKS * CHUNK, PAST_LEN)
    return {
        "x_prompt": nrm((BATCH, SEQ, D_MODEL), 1.0),
        "x_sample": nrm((DEC_BATCH, DEC_SEQ, D_MODEL), 1.0),
        "mem_prompt": nrm((BATCH, N_MEM, D_MODEL), 1.0),
        "cache_a_k": nrm((DEPTH, DEC_BATCH, a_keep, H_A, HEAD_DIM), 1.0),
        "cache_a_v": nrm((DEPTH, DEC_BATCH, a_keep, H_A, HEAD_DIM), 1.0),
        "state_gla": nrm((DEPTH, DEC_BATCH, H_B, DK_B, DV_B), 1.0),
        "cache_mem_k": nrm((DEPTH, DEC_BATCH, N_MEM, H_M, HEAD_DIM), 1.0),
        "cache_mem_v": nrm((DEPTH, DEC_BATCH, N_MEM, H_M, HEAD_DIM), 1.0),
        "norm_in": 1.0 + nrm((DEPTH, D_MODEL), 0.02),
        "w_in": nrm((DEPTH, D_MODEL, D_IN), D_MODEL ** -0.5),
        "g_qa": 1.0 + nrm((DEPTH, HEAD_DIM), 0.02),
        "g_ka": 1.0 + nrm((DEPTH, HEAD_DIM), 0.02),
        "rel_bias": nrm((DEPTH, H_A, 2 * REL_CLIP + 1), 0.5),
        "w_gate2": nrm((DEPTH, GATE_RANK, W_BK), GATE_RANK ** -0.5),
        "b_gate": nrm((DEPTH, W_BK), 0.1),
        "g_gla_out": 1.0 + nrm((DEPTH, DV_B), 0.02),
        "g_mem": 1.0 + nrm((DEPTH, D_MODEL), 0.02),
        "w_mem_kv": nrm((DEPTH, D_MODEL, 2 * W_M), D_MODEL ** -0.5),
        "g_qm": 1.0 + nrm((DEPTH, HEAD_DIM), 0.02),
        "g_km": 1.0 + nrm((DEPTH, HEAD_DIM), 0.02),
        "w_up_a": nrm((DEPTH, W_A, D_MODEL), W_A ** -0.5),
        "w_up_b": nrm((DEPTH, W_BV, D_MODEL), W_BV ** -0.5),
        "w_up_m": nrm((DEPTH, W_M, D_MODEL), W_M ** -0.5),
        "w_out": nrm((DEPTH, D_MODEL, D_MODEL), 0.5 * D_MODEL ** -0.5),
    }


def reference(x_prompt, x_sample, mem_prompt, cache_a_k, cache_a_v, state_gla, cache_mem_k,
              cache_mem_v, norm_in, w_in, g_qa, g_ka, rel_bias, w_gate2, b_gate, g_gla_out,
              g_mem, w_mem_kv, g_qm, g_km, w_up_a, w_up_b, w_up_m, w_out):
    xp, xs = x_prompt, x_sample
    keep_p = min(LEFT_CHUNKS * CHUNK, x_prompt.shape[1])
    akp, avp, sgp, mkp, mvp, aks, avs, sgs = [], [], [], [], [], [], [], []
    for l in range(DEPTH):
        weights = (norm_in[l], w_in[l], g_qa[l], g_ka[l], rel_bias[l], w_gate2[l], b_gate[l],
                   g_gla_out[l], g_qm[l], w_up_a[l], w_up_b[l], w_up_m[l], w_out[l])
        mk, mv = memory_kv(mem_prompt, g_mem[l], w_mem_kv[l], g_km[l])
        s0 = jnp.zeros((xp.shape[0], H_B, DK_B, DV_B), state_gla.dtype)
        xp, ka, va, sp = hybrid_layer(xp, band_attention_prompt, mk, mv, s0, *weights)
        akp.append(ka[:, -keep_p:])
        avp.append(va[:, -keep_p:])
        sgp.append(sp)
        mkp.append(mk)
        mvp.append(mv)
        past_k, past_v = cache_a_k[l], cache_a_v[l]
        attend_step = lambda q, k, v, tab: band_attention_step(q, k, v, past_k, past_v, tab)
        xs, ka_s, va_s, ss = hybrid_layer(xs, attend_step, cache_mem_k[l], cache_mem_v[l],
                                          state_gla[l], *weights)
        aks.append(ka_s)
        avs.append(va_s)
        sgs.append(ss)
    return (xp, xs, jnp.stack(akp), jnp.stack(avp), jnp.stack(sgp), jnp.stack(mkp), jnp.stack(mvp),
            jnp.stack(aks), jnp.stack(avs), jnp.stack(sgs))
```

```cpp
#include <hip/hip_runtime.h>
#include <hip/hip_cooperative_groups.h>
#include <cstdio>
#include <cstdint>
namespace cg = cooperative_groups;

#define LAS __attribute__((address_space(3)))
#define DI __device__ __forceinline__
typedef unsigned short bf16_t;
typedef short bf16x8 __attribute__((ext_vector_type(8)));
typedef float f32x2 __attribute__((ext_vector_type(2)));
typedef float f32x4 __attribute__((ext_vector_type(4)));
typedef float f32x16 __attribute__((ext_vector_type(16)));
typedef unsigned u32x2 __attribute__((ext_vector_type(2)));
typedef unsigned u32x4 __attribute__((ext_vector_type(4)));
typedef __bf16 bf2v __attribute__((ext_vector_type(2)));

DI unsigned pk2(float a, float b) { f32x2 v = {a, b}; bf2v r = __builtin_convertvector(v, bf2v); return __builtin_bit_cast(unsigned, r); }
DI bf16_t f2bf(float a) { return (bf16_t)(pk2(a, 0.f) & 0xffffu); }
DI float bf2f(bf16_t v) { return __uint_as_float(((unsigned)v) << 16); }
DI float bflo(unsigned w) { return __uint_as_float(w << 16); }
DI float bfhi(unsigned w) { return __uint_as_float(w & 0xffff0000u); }
DI u32x4 pack8(f32x4 a, f32x4 b) { u32x4 w; w.x = pk2(a[0], a[1]); w.y = pk2(a[2], a[3]); w.z = pk2(b[0], b[1]); w.w = pk2(b[2], b[3]); return w; }
#define MFMA32(a, b, c) __builtin_amdgcn_mfma_f32_32x32x16_bf16((a), (b), (c), 0, 0, 0)
#define LDS_WAIT() asm volatile("s_waitcnt lgkmcnt(0)" ::: "memory")

constexpr int T_P = 16384, T_ALL = 16896;
constexpr float EPS = 1e-6f;
constexpr float LOG2E = 1.4426950408889634f;
constexpr float QSCALE = 0.125f * LOG2E;

constexpr size_t OFF_WINT = 0;
constexpr size_t OFF_WUPA = OFF_WINT + 7424ull * 1024 * 2;
constexpr size_t OFF_WUPB = OFF_WUPA + 1024ull * 512 * 2;
constexpr size_t OFF_WUPM = OFF_WUPB + 1024ull * 512 * 2;
constexpr size_t OFF_WOUT = OFF_WUPM + 1024ull * 256 * 2;
constexpr size_t OFF_WMEM = OFF_WOUT + 1024ull * 1024 * 2;
constexpr size_t OFF_MEMH = OFF_WMEM + 512ull * 1024 * 2;
constexpr size_t OFF_H    = OFF_MEMH + 512ull * 1024 * 2;
constexpr size_t OFF_QA   = OFF_H + 16896ull * 1024 * 2;
constexpr size_t OFF_KA   = OFF_QA + 16896ull * 512 * 2;
constexpr size_t OFF_VAT  = OFF_KA + 16384ull * 512 * 2;
constexpr int VLD = 8320;
constexpr size_t OFF_KS   = OFF_VAT + 2ull * 512 * VLD * 2;
constexpr size_t OFF_VST  = OFF_KS + 32ull * 528 * 512 * 2 + 32768;
constexpr size_t OFF_ZA   = OFF_VST + 32ull * 512 * 528 * 2 + 32768;
constexpr size_t OFF_QB   = OFF_ZA + 16896ull * 512 * 2;
constexpr size_t OFF_KB   = OFF_QB + 16896ull * 256 * 2;
constexpr size_t OFF_VBT  = OFF_KB + 16896ull * 256 * 2;
constexpr size_t OFF_VBTS = OFF_VBT + 2ull * 512 * 8192 * 2;
constexpr size_t OFF_LOGA = OFF_VBTS + 32ull * 512 * 16 * 2;
constexpr size_t OFF_ZB   = OFF_LOGA + 16896ull * 256 * 4;
constexpr size_t OFF_QM   = OFF_ZB + 16896ull * 512 * 2;
constexpr size_t OFF_ZM   = OFF_QM + 16896ull * 256 * 2;
constexpr size_t OFF_MK   = OFF_ZM + 16896ull * 256 * 2;
constexpr size_t OFF_MVT  = OFF_MK + 512ull * 256 * 2;
constexpr size_t OFF_MKS  = OFF_MVT + 2ull * 256 * 256 * 2;
constexpr size_t OFF_MVST = OFF_MKS + 32ull * 256 * 256 * 2;
constexpr size_t OFF_DEC  = OFF_MVST + 32ull * 256 * 256 * 2;
constexpr size_t OFF_SGS  = OFF_DEC + 1024ull * 64 * 4;
constexpr size_t OFF_BAR  = OFF_SGS + 512ull * 3072 * 2;
constexpr size_t WS_END   = OFF_BAR + 16384;
constexpr size_t OFF_SG   = OFF_QA;
constexpr size_t OFF_UB   = OFF_SG + 16896ull * 1024 * 2;
static_assert(OFF_UB + 16896ull * 1024 * 2 <= OFF_ZA, "overlay");
static_assert(WS_END <= 268435456ull, "workspace");

constexpr size_t O_SPB = 8388608;
constexpr size_t O_Y = 0, O_AKP = 17301504, O_AVP = 17825792, O_GLP = 18350080, O_MKP = 18415616, O_MVP = 18546688,
                 O_AKS = 18677760, O_AVS = 18939904, O_GLS = 19202048;

constexpr int LDS_WAVE = 18432;
constexpr int LDS_TAB = 8448;
constexpr int LDS_BAR = LDS_TAB + 8 * LDS_WAVE;
constexpr int LDS_BYTES = LDS_BAR + 16;

struct Params {
    const float *x_prompt, *x_sample, *mem_prompt, *cache_a_k, *cache_a_v, *state_gla, *cache_mem_k, *cache_mem_v,
        *norm_in, *w_in, *g_qa, *g_ka, *rel_bias, *w_gate2, *b_gate, *g_gla_out, *g_mem, *w_mem_kv, *g_qm, *g_km,
        *w_up_a, *w_up_b, *w_up_m, *w_out;
    float* out;
    unsigned char* ws;
};

constexpr int HTB = 128 * 64 * 2;
#ifndef GEMM_SP2
#define GEMM_SP2 1
#endif
#ifndef GEMM_ALIGN
#define GEMM_ALIGN 1
#endif
DI int lds_byte(int r, int c) { const int st = (r >> 4) * 2 + (c >> 5), rr = r & 15, cc = c & 31, ob = rr * 64 + cc * 2; return st * 1024 + (ob ^ (((ob >> 9) & 1) << 5)); }
DI void stage_rc(int b, int& R, int& C) { const int st = b / 1024, sb = b % 1024, swz = sb ^ (((sb >> 9) & 1) << 5); R = (st >> 1) * 16 + swz / 64; C = (st & 1) * 32 + (swz % 64) / 2; }
DI int perm32(int rho) { const int n = rho >> 4, i = rho & 15; return 8 * (i >> 2) + 4 * n + (i & 3); }

enum { K_QNORM = 0, K_KNORM, K_MEMK, K_VA, K_VB, K_MEMV, K_SILU, K_SCALE, K_LOGA, K_GATE, K_UP0, K_UP1, K_OUT };
struct Unit { const char* A; const char* B; int nt; int ldb; int kind; int pm; int coff; int aux; };

DI void static_order(int L, int nM, int nN, int nwg, int& pm, int& pn) {
    int wgid = L; { const int q = nwg / 8, r = nwg % 8, xcd = wgid % 8, off = wgid / 8; wgid = (xcd < r ? xcd * (q + 1) : r * (q + 1) + (xcd - r) * q) + off; }
    const int nig = 8 * nN, gid = wgid / nig, fm = gid * 8, gsz = (nM - fm) < 8 ? (nM - fm) : 8;
    pm = fm + ((wgid % nig) % gsz); pn = (wgid % nig) / gsz;
}

template <int PH> DI bool get_unit(const Params& p, int i, Unit& u, int mode) {
    const int G = gridDim.x, c = blockIdx.x;
    const char* ws = (const char*)p.ws;
    if constexpr (PH == 1) {
        const int L = i * G + c; constexpr int nwg = 66 * 17;
        if (L >= nwg + 4 + 24) return false;
        u.nt = 16; u.ldb = 2048; u.aux = 0; u.coff = 0;
        if (L >= nwg + 4) {
            const int e = L - nwg - 4, pm = 64 + e / 12, gt = e % 12;
            u.pm = pm; u.kind = K_GATE; u.coff = gt * 256;
            u.A = ws + OFF_H + (size_t)pm * 256 * 2048; u.B = ws + OFF_WINT + (size_t)(17 + gt) * 256 * 2048;
            return true;
        }
        if (L >= nwg) {
            const int e = L - nwg, pmm = e >> 1;
            u.pm = pmm;
            if ((e & 1) == 0) { u.kind = K_MEMK; u.A = ws + OFF_MEMH + (size_t)pmm * 256 * 2048; u.B = ws + OFF_WMEM; }
            else { u.kind = K_MEMV; u.A = ws + OFF_WMEM + (size_t)256 * 2048; u.B = ws + OFF_MEMH + (size_t)pmm * 256 * 2048; }
            return true;
        }
        int pm, t; static_order(L, 66, 17, nwg, pm, t);
        u.pm = pm;
        const char* hp = ws + OFF_H + (size_t)pm * 256 * 2048; const char* wp = ws + OFF_WINT + (size_t)t * 256 * 2048;
        const bool sw = (t == 4 || t == 5 || t == 10 || t == 11);
        u.A = sw ? wp : hp; u.B = sw ? hp : wp;
        if (t < 2) { u.kind = K_QNORM; u.coff = t * 256; }
        else if (t < 4) { u.kind = K_KNORM; u.coff = (t - 2) * 256; }
        else if (t < 6) { u.kind = K_VA; u.coff = (t - 4) * 256; }
        else if (t < 8) { u.kind = K_SILU; u.coff = (t - 6) * 256; }
        else if (t == 8) { u.kind = K_SCALE; }
        else if (t == 9) { u.kind = K_SCALE; u.aux = 1; }
        else if (t < 12) { u.kind = K_VB; u.coff = (t - 10) * 256; }
        else if (t == 12) { u.kind = K_LOGA; }
        else if (t < 15) { u.kind = K_SILU; u.aux = 1; u.coff = (t - 13) * 256; }
        else if (t == 15) { u.kind = K_QNORM; u.aux = 1; }
        else { u.kind = K_SILU; u.aux = 2; }
        return true;
    } else if constexpr (PH == 5) {
        int pm, pn, br, isup;
        if (mode == 0) {
            const int gi = i / 6, s = i - gi * 6, L = gi * G + c;
            if (L >= 256) return false;
            static_order(L, 64, 4, 256, pm, pn);
            br = s >> 1; isup = s & 1; u.aux = 0;
        } else {
            if (i >= 3 || c >= 8) return false;
            pm = 64 + (c >> 2); pn = c & 3; br = i; isup = 1; u.aux = 1 + br;
        }
        u.pm = pm; u.coff = pn * 256;
        if (!isup) {
            u.kind = K_GATE; u.nt = 16; u.ldb = 2048;
            u.A = ws + OFF_H + (size_t)pm * 256 * 2048; u.B = ws + OFF_WINT + (size_t)(17 + 4 * br + pn) * 256 * 2048;
        } else {
            u.kind = br == 0 ? K_UP0 : K_UP1;
            if (br == 0) { u.nt = 8; u.ldb = 1024; u.A = ws + OFF_ZA + (size_t)pm * 256 * 1024; u.B = ws + OFF_WUPA + (size_t)pn * 256 * 1024; }
            else if (br == 1) { u.nt = 8; u.ldb = 1024; u.A = ws + OFF_ZB + (size_t)pm * 256 * 1024; u.B = ws + OFF_WUPB + (size_t)pn * 256 * 1024; }
            else { u.nt = 4; u.ldb = 512; u.A = ws + OFF_ZM + (size_t)pm * 256 * 512; u.B = ws + OFF_WUPM + (size_t)pn * 256 * 512; }
        }
        return true;
    } else {
        int pm, pn;
        if (mode == 0) { const int L = i * G + c; if (L >= 256) return false; static_order(L, 64, 4, 256, pm, pn); }
        else { if (i >= 1 || c >= 8) return false; pm = 64 + (c >> 2); pn = c & 3; }
        u.pm = pm; u.coff = pn * 256; u.aux = 0; u.kind = K_OUT; u.nt = 16; u.ldb = 2048;
        u.A = ws + OFF_UB + (size_t)pm * 256 * 2048; u.B = ws + OFF_WOUT + (size_t)pn * 256 * 2048;
        return true;
    }
}

DI float sigmoidf_(float v) { return __fdividef(1.f, 1.f + __expf(-v)); }

template <int PH>
DI void epilogue(const Params& p, const f32x4 (&acc)[2][2][4][2], const Unit& u, int wr, int wc, int fr, int fq) {
    unsigned char* ws = p.ws;
    const int kind = u.kind;
    const int rl0 = 64 * wr + fr;
    const int cl0 = 64 * wc + 8 * fq;
    if constexpr (PH == 1) {
        if (kind <= K_MEMK) {
            const float* g = kind == K_QNORM ? (u.aux ? p.g_qm : p.g_qa) : (kind == K_KNORM ? p.g_ka : p.g_km);
            const float sc = kind == K_QNORM ? QSCALE : 1.f;
            f32x4 gv[2][2];
#pragma unroll
            for (int bj = 0; bj < 2; ++bj)
#pragma unroll
                for (int n = 0; n < 2; ++n) gv[bj][n] = *(const f32x4*)(g + 32 * bj + 8 * fq + 4 * n) * sc;
#pragma unroll
            for (int ai = 0; ai < 2; ++ai)
#pragma unroll
                for (int m = 0; m < 4; ++m) {
                    const int r = u.pm * 256 + rl0 + 128 * ai + 16 * m;
                    float ss = 0.f;
#pragma unroll
                    for (int bj = 0; bj < 2; ++bj)
#pragma unroll
                        for (int n = 0; n < 2; ++n) { const f32x4 v = acc[ai][bj][m][n]; ss += v[0] * v[0] + v[1] * v[1] + v[2] * v[2] + v[3] * v[3]; }
                    ss += __shfl_xor(ss, 16); ss += __shfl_xor(ss, 32);
                    const float rstd = rsqrtf(ss * (1.f / 64.f) + EPS);
                    bf16_t* d16; float* d32 = nullptr;
                    if (kind == K_QNORM) {
                        d16 = u.aux ? (bf16_t*)(ws + OFF_QM) + (size_t)r * 256 + cl0 : (bf16_t*)(ws + OFF_QA) + (size_t)r * 512 + u.coff + cl0;
                    } else if (kind == K_KNORM) {
                        if (u.pm < 64) {
                            d16 = (bf16_t*)(ws + OFF_KA) + (size_t)r * 512 + u.coff + cl0;
                            if ((u.pm & 31) >= 30) d32 = p.out + O_AKP + (size_t)((r >> 13) * 512 + (r & 8191) - 7680) * 512 + u.coff + cl0;
                        } else {
                            const int rs = r - T_P;
                            d16 = (bf16_t*)(ws + OFF_KS) + (size_t)(rs + 512 * ((rs >> 4) + 1)) * 512 + u.coff + cl0;
                            d32 = p.out + O_AKS + (size_t)rs * 512 + u.coff + cl0;
                        }
                    } else {
                        d16 = (bf16_t*)(ws + OFF_MK) + (size_t)r * 256 + cl0;
                        d32 = p.out + O_MKP + (size_t)r * 256 + cl0;
                    }
#pragma unroll
                    for (int bj = 0; bj < 2; ++bj) {
                        const f32x4 v0 = acc[ai][bj][m][0] * rstd * gv[bj][0], v1 = acc[ai][bj][m][1] * rstd * gv[bj][1];
                        *(u32x4*)(d16 + 32 * bj) = pack8(v0, v1);
                        if (d32) { *(f32x4*)(d32 + 32 * bj) = v0; *(f32x4*)(d32 + 32 * bj + 4) = v1; }
                    }
                }
        } else if (kind <= K_MEMV) {
#pragma unroll
            for (int ai = 0; ai < 2; ++ai)
#pragma unroll
                for (int m = 0; m < 4; ++m) {
                    const int f = u.coff + rl0 + 128 * ai + 16 * m;
#pragma unroll
                    for (int bj = 0; bj < 2; ++bj) {
                        const int tc = 128 * bj + 32 * wc + 8 * fq;
                        const f32x4 v0 = acc[ai][bj][m][0], v1 = acc[ai][bj][m][1];
                        const u32x4 w = pack8(v0, v1);
                        if (kind == K_MEMV) {
                            const int b = u.pm;
                            *(u32x4*)((bf16_t*)(ws + OFF_MVT) + (size_t)(b * 256 + f) * 256 + tc) = w;
                            float* o = p.out + O_MVP + (size_t)(b * 256 + tc) * 256 + f;
#pragma unroll
                            for (int j = 0; j < 4; ++j) { o[(size_t)j * 256] = v0[j]; o[(size_t)(4 + j) * 256] = v1[j]; }
                        } else if (u.pm < 64) {
                            const int b = u.pm >> 5, t = (u.pm & 31) * 256 + tc;
                            if (kind == K_VA) *(u32x4*)((bf16_t*)(ws + OFF_VAT) + (size_t)(b * 512 + f) * VLD + t) = w;
                            else *(u32x4*)((bf16_t*)(ws + OFF_VBT) + ((size_t)(((b * 4 + (f >> 7)) * 128 + (t >> 6)) * 4 + ((f & 127) >> 5)) * 8 + ((t & 63) >> 3)) * 256 + (f & 31) * 8) = w;
                            if (kind == K_VA && (u.pm & 31) >= 30) {
                                float* o = p.out + O_AVP + (size_t)(b * 512 + t - 7680) * 512 + f;
#pragma unroll
                                for (int j = 0; j < 4; ++j) { o[(size_t)j * 512] = v0[j]; o[(size_t)(4 + j) * 512] = v1[j]; }
                            }
                        } else {
                            const int rs = (u.pm - 64) * 256 + tc, sb = rs >> 4, i = rs & 15;
                            if (kind == K_VA) {
                                *(u32x4*)((bf16_t*)(ws + OFF_VST) + (size_t)(sb * 512 + f) * 528 + 512 + i) = w;
                                float* o = p.out + O_AVS + (size_t)rs * 512 + f;
#pragma unroll
                                for (int j = 0; j < 4; ++j) { o[(size_t)j * 512] = v0[j]; o[(size_t)(4 + j) * 512] = v1[j]; }
                            } else {
                                *(u32x4*)((bf16_t*)(ws + OFF_VBTS) + (size_t)(sb * 512 + f) * 16 + i) = w;
                            }
                        }
                    }
                }
        } else if (kind == K_LOGA) {
            f32x4 bv[2][2];
#pragma unroll
            for (int bj = 0; bj < 2; ++bj)
#pragma unroll
                for (int n = 0; n < 2; ++n) bv[bj][n] = *(const f32x4*)(p.b_gate + cl0 + 32 * bj + 4 * n);
#pragma unroll
            for (int ai = 0; ai < 2; ++ai)
#pragma unroll
                for (int m = 0; m < 4; ++m) {
                    const int r = u.pm * 256 + rl0 + 128 * ai + 16 * m;
                    float* d = (float*)(ws + OFF_LOGA) + (size_t)r * 256 + cl0;
#pragma unroll
                    for (int bj = 0; bj < 2; ++bj)
#pragma unroll
                        for (int n = 0; n < 2; ++n) {
                            const f32x4 x = acc[ai][bj][m][n] + bv[bj][n]; f32x4 o;
#pragma unroll
                            for (int j = 0; j < 4; ++j) o[j] = -(fmaxf(-x[j], 0.f) + __logf(1.f + __expf(-fabsf(x[j])))) * (1.f / 16.f);
                            *(f32x4*)(d + 32 * bj + 4 * n) = o;
                        }
                }
        } else {
            bf16_t* base; int ld; float sc = 1.f;
            if (kind == K_GATE) { base = (bf16_t*)(ws + OFF_SGS) - (size_t)T_P * 3072; ld = 3072; }
            else if (kind == K_SILU) { base = (bf16_t*)(ws + (u.aux == 0 ? OFF_ZA : (u.aux == 1 ? OFF_ZB : OFF_ZM))); ld = u.aux == 2 ? 256 : 512; }
            else { base = (bf16_t*)(ws + (u.aux == 0 ? OFF_QB : OFF_KB)); ld = 256; sc = u.aux == 0 ? 0.125f : 1.f; }
#pragma unroll
            for (int ai = 0; ai < 2; ++ai)
#pragma unroll
                for (int m = 0; m < 4; ++m) {
                    const int r = u.pm * 256 + rl0 + 128 * ai + 16 * m;
                    bf16_t* d = base + (size_t)r * ld + u.coff + cl0;
#pragma unroll
                    for (int bj = 0; bj < 2; ++bj) {
                        f32x4 v0 = acc[ai][bj][m][0], v1 = acc[ai][bj][m][1];
                        if (kind == K_SILU) {
#pragma unroll
                            for (int j = 0; j < 4; ++j) { v0[j] = v0[j] * sigmoidf_(v0[j]); v1[j] = v1[j] * sigmoidf_(v1[j]); }
                        } else if (kind == K_GATE) {
#pragma unroll
                            for (int j = 0; j < 4; ++j) { v0[j] = sigmoidf_(v0[j]); v1[j] = sigmoidf_(v1[j]); }
                        } else { v0 = v0 * sc; v1 = v1 * sc; }
                        *(u32x4*)(d + 32 * bj) = pack8(v0, v1);
                    }
                }
        }
    } else if constexpr (PH == 5) {
        const bf16_t* gsrc = u.aux == 0 ? (const bf16_t*)(ws + OFF_SG) + u.coff + cl0 : (const bf16_t*)(ws + OFF_SGS) - (size_t)T_P * 3072 + (u.aux - 1) * 1024 + u.coff + cl0;
        const int gld = u.aux == 0 ? 1024 : 3072;
#pragma unroll
        for (int ai = 0; ai < 2; ++ai) {
            if (kind == K_GATE) {
#pragma unroll
                for (int m = 0; m < 4; ++m) {
                    const int r = u.pm * 256 + rl0 + 128 * ai + 16 * m;
                    bf16_t* sg = (bf16_t*)(ws + OFF_SG) + (size_t)r * 1024 + u.coff + cl0;
#pragma unroll
                    for (int bj = 0; bj < 2; ++bj) {
                        f32x4 v0 = acc[ai][bj][m][0], v1 = acc[ai][bj][m][1];
#pragma unroll
                        for (int j = 0; j < 4; ++j) { v0[j] = sigmoidf_(v0[j]); v1[j] = sigmoidf_(v1[j]); }
                        *(u32x4*)(sg + 32 * bj) = pack8(v0, v1);
                    }
                }
            } else {
                u32x4 sv[4][2], qv[4][2];
#pragma unroll
                for (int m = 0; m < 4; ++m) {
                    const int r = u.pm * 256 + rl0 + 128 * ai + 16 * m;
#pragma unroll
                    for (int bj = 0; bj < 2; ++bj) {
                        sv[m][bj] = *(const u32x4*)(gsrc + (size_t)r * gld + 32 * bj);
                        if (kind == K_UP1) qv[m][bj] = *(const u32x4*)((const bf16_t*)(ws + OFF_UB) + (size_t)r * 1024 + u.coff + cl0 + 32 * bj);
                    }
                }
#pragma unroll
                for (int m = 0; m < 4; ++m) {
                    const int r = u.pm * 256 + rl0 + 128 * ai + 16 * m;
                    bf16_t* ub = (bf16_t*)(ws + OFF_UB) + (size_t)r * 1024 + u.coff + cl0;
#pragma unroll
                    for (int bj = 0; bj < 2; ++bj) {
                        f32x4 v0 = acc[ai][bj][m][0], v1 = acc[ai][bj][m][1];
                        const u32x4 sq = sv[m][bj];
                        v0[0] *= bflo(sq.x); v0[1] *= bfhi(sq.x); v0[2] *= bflo(sq.y); v0[3] *= bfhi(sq.y);
                        v1[0] *= bflo(sq.z); v1[1] *= bfhi(sq.z); v1[2] *= bflo(sq.w); v1[3] *= bfhi(sq.w);
                        if (kind == K_UP1) {
                            const u32x4 q = qv[m][bj];
                            v0[0] += bflo(q.x); v0[1] += bfhi(q.x); v0[2] += bflo(q.y); v0[3] += bfhi(q.y);
                            v1[0] += bflo(q.z); v1[1] += bfhi(q.z); v1[2] += bflo(q.w); v1[3] += bfhi(q.w);
                        }
                        *(u32x4*)(ub + 32 * bj) = pack8(v0, v1);
                    }
                }
            }
        }
    } else {
#pragma unroll
        for (int ai = 0; ai < 2; ++ai) {
            f32x4 xv[4][2][2];
#pragma unroll
            for (int m = 0; m < 4; ++m) {
                const int r = u.pm * 256 + rl0 + 128 * ai + 16 * m;
                const float* xr = (r < T_P ? p.x_prompt + (size_t)r * 1024 : p.x_sample + (size_t)(r - T_P) * 1024) + u.coff + cl0;
#pragma unroll
                for (int bj = 0; bj < 2; ++bj)
#pragma unroll
                    for (int n = 0; n < 2; ++n) xv[m][bj][n] = *(const f32x4*)(xr + 32 * bj + 4 * n);
            }
#pragma unroll
            for (int m = 0; m < 4; ++m) {
                const int r = u.pm * 256 + rl0 + 128 * ai + 16 * m;
                float* yr = p.out + O_Y + (size_t)r * 1024 + u.coff + cl0;
#pragma unroll
                for (int bj = 0; bj < 2; ++bj)
#pragma unroll
                    for (int n = 0; n < 2; ++n) *(f32x4*)(yr + 32 * bj + 4 * n) = acc[ai][bj][m][n] + xv[m][bj][n];
            }
        }
    }
}

template <int PH>
DI void gemm_phase(const Params& p, LAS unsigned char* lds, int mode) {
    int tid = threadIdx.x; asm volatile("" : "+v"(tid));
    const int wid = __builtin_amdgcn_readfirstlane(tid >> 6), lane = tid & 63, wr = wid >> 2, wc = wid & 3, fr = lane & 15, fq = lane >> 4;
    int rA[2], rB[2], c2[2];
#pragma unroll
    for (int i = 0; i < 2; ++i) { int R, C; stage_rc(tid * 16 + i * 8192, R, C); rA[i] = R; rB[i] = (R & ~31) + perm32(R & 31); c2[i] = C * 2; }
    const unsigned ldsw = (unsigned)wid * 1024u;
    const int aoff = lds_byte(wr * 64 + fr, fq * 8), boff = lds_byte(wc * 32 + fr, fq * 8);
#define G_SA(b, h) (((b) * 2 + (h)) * HTB)
#define G_SB(b, h) ((4 + (b) * 2 + (h)) * HTB)
#define G_STAGE(bufoff, gbase, rows, ldbv) do { _Pragma("unroll") for (int _i = 0; _i < 2; ++_i) \
        __builtin_amdgcn_global_load_lds((const unsigned*)((const char*)(gbase) + (unsigned)((rows)[_i] * (ldbv) + c2[_i])), (LAS unsigned*)(lds + (bufoff) + ldsw + _i * 8192), 16, 0, 0); } while (0)
#define G_LDA(dst, b, h) do { _Pragma("unroll") for (int m = 0; m < 4; ++m) _Pragma("unroll") for (int k = 0; k < 2; ++k) dst[m][k] = *(const LAS bf16x8*)(lds + G_SA(b, h) + aoff + m * 2048 + k * 1024); } while (0)
#define G_LDB(dst, b, h) do { _Pragma("unroll") for (int n = 0; n < 2; ++n) _Pragma("unroll") for (int k = 0; k < 2; ++k) dst[n][k] = *(const LAS bf16x8*)(lds + G_SB(b, h) + boff + n * 2048 + k * 1024); } while (0)
#define G_MMA(ai, bj, At, Bt) do { __builtin_amdgcn_s_setprio(1); _Pragma("unroll") for (int m = 0; m < 4; ++m) _Pragma("unroll") for (int n = 0; n < 2; ++n) _Pragma("unroll") for (int k = 0; k < 2; ++k) \
        acc[ai][bj][m][n] = __builtin_amdgcn_mfma_f32_16x16x32_bf16(Bt[n][k], At[m][k], acc[ai][bj][m][n], 0, 0, 0); __builtin_amdgcn_s_setprio(0); } while (0)
#define G_WAIT_V(n) asm volatile("s_waitcnt vmcnt(" #n ")" ::: "memory")
#define G_WAIT_L(n) asm volatile("s_waitcnt lgkmcnt(" #n ")" ::: "memory")
#define G_BAR __builtin_amdgcn_s_barrier()
#define G_SCHED __builtin_amdgcn_sched_barrier(0)
    Unit cur, nxt; int ui = 0;
    if (!get_unit<PH>(p, 0, cur, mode)) return;
    f32x4 acc[2][2][4][2];
#pragma unroll
    for (int a = 0; a < 2; ++a)
#pragma unroll
        for (int b = 0; b < 2; ++b)
#pragma unroll
            for (int m = 0; m < 4; ++m)
#pragma unroll
                for (int n = 0; n < 2; ++n) acc[a][b][m][n] = (f32x4){0.f, 0.f, 0.f, 0.f};
    bf16x8 At[4][2], B0[2][2], B1[2][2];
    const char* cA = cur.A; const char* cB = cur.B; int cl = cur.ldb; size_t ch = (size_t)128 * cl;
    if (GEMM_SP2) {
        G_STAGE(G_SB(0, 0), cB, rB, cl); G_STAGE(G_SB(0, 1), cB + ch, rB, cl); G_STAGE(G_SA(0, 0), cA, rA, cl); G_STAGE(G_SA(0, 1), cA + ch, rA, cl);
        if (wr == 1) G_BAR;
        G_WAIT_V(2); G_BAR;
        G_STAGE(G_SB(1, 0), cB + 128, rB, cl); G_STAGE(G_SA(1, 0), cA + 128, rA, cl); G_STAGE(G_SB(1, 1), cB + ch + 128, rB, cl);
        G_WAIT_V(6); G_BAR;
    } else {
        G_STAGE(G_SB(0, 0), cB, rB, cl); G_STAGE(G_SA(0, 0), cA, rA, cl); G_STAGE(G_SB(0, 1), cB + ch, rB, cl); G_STAGE(G_SA(0, 1), cA + ch, rA, cl);
        if (wr == 1) G_BAR;
        G_WAIT_V(4); G_BAR;
        G_STAGE(G_SB(1, 0), cB + 128, rB, cl); G_STAGE(G_SA(1, 0), cA + 128, rA, cl); G_STAGE(G_SB(1, 1), cB + ch + 128, rB, cl);
        G_WAIT_V(6); G_BAR;
    }
    for (;;) {
        const bool has_next = get_unit<PH>(p, ui + 1, nxt, mode);
        const char* nA = has_next ? nxt.A : cA; const char* nB = has_next ? nxt.B : cB; const int nl = has_next ? nxt.ldb : cl; const size_t nh = (size_t)128 * nl;
        const int nt = cur.nt;
        for (int t = 0; t < nt; t += 2) {
            const bool last = (t == nt - 2);
            const char* a1 = cA + (size_t)(t + 1) * 128;
            const char* a2 = last ? nA : cA + (size_t)(t + 2) * 128; const char* b2 = last ? nB : cB + (size_t)(t + 2) * 128;
            const int l2 = last ? nl : cl; const size_t h2 = last ? nh : ch;
            const char* a3 = a2 + 128; const char* b3 = b2 + 128;
            if (GEMM_SP2) {
                G_LDB(B0, 0, 0); G_LDB(B1, 0, 1); G_SCHED; G_LDA(At, 0, 0); G_STAGE(G_SA(1, 1), a1 + ch, rA, cl);
                G_WAIT_V(8); G_WAIT_L(0); G_BAR; G_MMA(0, 0, At, B0); G_MMA(0, 1, At, B1); G_BAR; G_SCHED;
                G_LDA(At, 0, 1); G_STAGE(G_SB(0, 0), b2, rB, l2); G_STAGE(G_SB(0, 1), b2 + h2, rB, l2); G_STAGE(G_SA(0, 0), a2, rA, l2);
                G_WAIT_V(8); G_WAIT_L(0); G_BAR; G_MMA(1, 0, At, B0); G_MMA(1, 1, At, B1); G_BAR; G_SCHED;
                G_LDB(B0, 1, 0); G_LDB(B1, 1, 1); G_SCHED; G_LDA(At, 1, 0); G_STAGE(G_SA(0, 1), a2 + h2, rA, l2);
                G_WAIT_V(8); G_WAIT_L(0); G_BAR; G_MMA(0, 0, At, B0); G_MMA(0, 1, At, B1); G_BAR; G_SCHED;
                G_LDA(At, 1, 1); G_STAGE(G_SB(1, 0), b3, rB, l2); G_STAGE(G_SB(1, 1), b3 + h2, rB, l2); G_STAGE(G_SA(1, 0), a3, rA, l2);
                G_WAIT_V(8); G_WAIT_L(0); G_BAR; G_MMA(1, 0, At, B0); G_MMA(1, 1, At, B1); G_BAR; G_SCHED;
            } else {
                G_LDB(B0, 0, 0); G_SCHED; G_LDA(At, 0, 0); G_STAGE(G_SA(1, 1), a1 + ch, rA, cl);
                G_WAIT_L(8); G_BAR; G_WAIT_L(0); G_MMA(0, 0, At, B0); G_BAR; G_SCHED;
                G_LDB(B1, 0, 1); G_STAGE(G_SB(0, 0), b2, rB, l2);
                G_BAR; G_WAIT_L(0); G_MMA(0, 1, At, B1); G_BAR;
                G_LDA(At, 0, 1); G_STAGE(G_SA(0, 0), a2, rA, l2);
                G_BAR; G_WAIT_L(0); G_MMA(1, 0, At, B0); G_BAR; G_SCHED;
                G_STAGE(G_SB(0, 1), b2 + h2, rB, l2);
                G_WAIT_V(6); G_BAR; G_MMA(1, 1, At, B1); G_BAR;
                G_LDB(B0, 1, 0); G_SCHED; G_LDA(At, 1, 0); G_STAGE(G_SA(0, 1), a2 + h2, rA, l2);
                G_WAIT_L(8); G_BAR; G_WAIT_L(0); G_MMA(0, 0, At, B0); G_BAR; G_SCHED;
                G_LDB(B1, 1, 1); G_STAGE(G_SB(1, 0), b3, rB, l2);
                G_BAR; G_WAIT_L(0); G_MMA(0, 1, At, B1); G_BAR;
                G_LDA(At, 1, 1); G_STAGE(G_SA(1, 0), a3, rA, l2);
                G_BAR; G_WAIT_L(0); G_MMA(1, 0, At, B0); G_BAR; G_SCHED;
                G_STAGE(G_SB(1, 1), b3 + h2, rB, l2);
                G_WAIT_V(6); G_BAR; G_MMA(1, 1, At, B1); G_BAR;
            }
        }
        if (GEMM_ALIGN) { if (wr == 0) G_BAR; }
        epilogue<PH>(p, acc, cur, wr, wc, fr, fq);
        if (!has_next) break;
#pragma unroll
        for (int a = 0; a < 2; ++a)
#pragma unroll
            for (int b = 0; b < 2; ++b)
#pragma unroll
                for (int m = 0; m < 4; ++m)
#pragma unroll
                    for (int n = 0; n < 2; ++n) acc[a][b][m][n] = (f32x4){0.f, 0.f, 0.f, 0.f};
        cur = nxt; cA = nA; cB = nB; cl = nl; ch = nh; ++ui;
        if (GEMM_ALIGN) { if (wr == 1) G_BAR; }
    }
    G_WAIT_V(0);
    if (!GEMM_ALIGN) { if (wr == 0) G_BAR; }
    G_BAR;
}

DI void transpose_item(const float* W, int ldw, bf16_t* WT, int ldt, LAS float* scr, int lane) {
    float tv[32];
#pragma unroll
    for (int i = 0; i < 32; ++i) tv[i] = W[(size_t)(2 * i + (lane >> 5)) * ldw + (lane & 31)];
#pragma unroll
    for (int i = 0; i < 32; ++i) scr[(2 * i + (lane >> 5)) * 33 + (lane & 31)] = tv[i];
    LDS_WAIT();
    const int c = lane & 7;
#pragma unroll
    for (int j = 0; j < 4; ++j) {
        const int n = (lane >> 3) + 8 * j; const LAS float* s = scr + (8 * c) * 33 + n;
        u32x4 o; o.x = pk2(s[0 * 33], s[1 * 33]); o.y = pk2(s[2 * 33], s[3 * 33]); o.z = pk2(s[4 * 33], s[5 * 33]); o.w = pk2(s[6 * 33], s[7 * 33]);
        *(u32x4*)(WT + (size_t)n * ldt + 8 * c) = o;
    }
    LDS_WAIT();
}

DI float wave_sum(float v) {
#pragma unroll
    for (int o = 1; o < 64; o <<= 1) v += __shfl_xor(v, o);
    return v;
}

DI void rows_job(const float* src, const float* g, bf16_t* dst, int nrows, int woff, int gw, int NGW, int lane) {
    int s0 = gw - woff; if (s0 < 0) s0 += NGW;
    for (int r0 = s0; r0 < nrows; r0 += 4 * NGW) {
        f32x4 v[4][4];
#pragma unroll
        for (int q = 0; q < 4; ++q) {
            const int r = r0 + q * NGW;
            if (r < nrows) {
#pragma unroll
                for (int j = 0; j < 4; ++j) v[q][j] = ((const f32x4*)(src + (size_t)r * 1024))[lane + 64 * j]; }
        }
#pragma unroll
        for (int q = 0; q < 4; ++q) {
            const int r = r0 + q * NGW;
            if (r < nrows) {
                float ssum = 0.f;
#pragma unroll
                for (int j = 0; j < 4; ++j) ssum += (v[q][j][0] * v[q][j][0] + v[q][j][1] * v[q][j][1]) + (v[q][j][2] * v[q][j][2] + v[q][j][3] * v[q][j][3]);
                const float rstd = rsqrtf(wave_sum(ssum) * (1.f / 1024.f) + EPS);
#pragma unroll
                for (int j = 0; j < 4; ++j) { const f32x4 gg = ((const f32x4*)g)[lane + 64 * j]; u32x2 w; w.x = pk2(v[q][j][0] * rstd * gg[0], v[q][j][1] * rstd * gg[1]); w.y = pk2(v[q][j][2] * rstd * gg[2], v[q][j][3] * rstd * gg[3]); ((u32x2*)(dst + (size_t)r * 1024))[lane + 64 * j] = w; }
            }
        }
    }
}

DI int lgrp(int g) { return 2 * (g & 3) + (g >> 2); }

DI void p0_prep(const Params& p, LAS unsigned char* lds) {
    int tid = threadIdx.x; asm volatile("" : "+v"(tid));
    const int lane = tid & 63, wid = __builtin_amdgcn_readfirstlane(tid >> 6);
    const int gw = blockIdx.x * 8 + wid, NGW = gridDim.x * 8;
    unsigned char* ws = p.ws;
    LAS float* scr = (LAS float*)(lds + wid * 8448);
    constexpr int J1 = 28 * 128, J2 = J1 + 256, J3 = J2 + 256, J4 = J3 + 256, J5 = J4 + 128, J6 = J5 + 512;
    for (int it = gw; it < J6; it += NGW) {
        if (it < J1) {
            int t = it >> 7; const int rem = it & 127, g = rem >> 4, kb = rem & 15; if (t >= 12) t += 1;
            const bool sw = (t == 4 || t == 5 || t == 10 || t == 11);
            const int src = (t < 12 ? 256 * t : 256 * (t - 1) + 16) + 32 * (sw ? g : lgrp(g));
            transpose_item(p.w_in + (size_t)(64 * kb) * 7184 + src, 7184, (bf16_t*)(ws + OFF_WINT) + (size_t)(t * 256 + 32 * g) * 1024 + 64 * kb, 1024, scr, lane);
        } else if (it < J2) {
            const int j = it - J1, t = j >> 7, rem = j & 127, g = rem >> 4, kb = rem & 15;
            const int src = 256 * t + 32 * (t ? g : lgrp(g));
            transpose_item(p.w_mem_kv + (size_t)(64 * kb) * 512 + src, 512, (bf16_t*)(ws + OFF_WMEM) + (size_t)(t * 256 + 32 * g) * 1024 + 64 * kb, 1024, scr, lane);
        } else if (it < J4) {
            const int j0 = it - J2, which = j0 >> 8, j = j0 & 255, t = j >> 6, rem = j & 63, g = rem >> 3, kb = rem & 7;
            const float* W = which ? p.w_up_b : p.w_up_a;
            transpose_item(W + (size_t)(64 * kb) * 1024 + 256 * t + 32 * lgrp(g), 1024, (bf16_t*)(ws + (which ? OFF_WUPB : OFF_WUPA)) + (size_t)(t * 256 + 32 * g) * 512 + 64 * kb, 512, scr, lane);
        } else if (it < J5) {
            const int j = it - J4, t = j >> 5, rem = j & 31, g = rem >> 2, kb = rem & 3;
            transpose_item(p.w_up_m + (size_t)(64 * kb) * 1024 + 256 * t + 32 * lgrp(g), 1024, (bf16_t*)(ws + OFF_WUPM) + (size_t)(t * 256 + 32 * g) * 256 + 64 * kb, 256, scr, lane);
        } else {
            const int j = it - J5, t = j >> 7, rem = j & 127, g = rem >> 4, kb = rem & 15;
            transpose_item(p.w_out + (size_t)(64 * kb) * 1024 + 256 * t + 32 * lgrp(g), 1024, (bf16_t*)(ws + OFF_WOUT) + (size_t)(t * 256 + 32 * g) * 1024 + 64 * kb, 1024, scr, lane);
        }
    }
    rows_job(p.x_prompt, p.norm_in, (bf16_t*)(ws + OFF_H), T_P, 0, gw, NGW, lane);
    rows_job(p.x_sample, p.norm_in, (bf16_t*)(ws + OFF_H) + (size_t)T_P * 1024, 512, 0, gw, NGW, lane);
    rows_job(p.mem_prompt, p.g_mem, (bf16_t*)(ws + OFF_MEMH), 512, 512, gw, NGW, lane);
    if (tid < 128) {
        for (int j = tid * gridDim.x + blockIdx.x; j < 32768; j += 128 * gridDim.x) {
            const int prow = j >> 7, kc = j & 127;
            const int g = prow >> 5, l = 32 * lgrp(g) + (prow & 31);
            float w2[16];
#pragma unroll
            for (int r = 0; r < 16; ++r) w2[r] = p.w_gate2[r * 256 + l];
            float o[8];
#pragma unroll
            for (int kk = 0; kk < 8; ++kk) {
                const f32x4* wr4 = (const f32x4*)(p.w_in + (size_t)(8 * kc + kk) * 7184 + 3072);
                float sacc = 0.f;
#pragma unroll
                for (int q = 0; q < 4; ++q) { const f32x4 v = wr4[q]; sacc += v[0] * w2[4 * q] + v[1] * w2[4 * q + 1] + v[2] * w2[4 * q + 2] + v[3] * w2[4 * q + 3]; }
                o[kk] = sacc;
            }
            u32x4 w; w.x = pk2(o[0], o[1]); w.y = pk2(o[2], o[3]); w.z = pk2(o[4], o[5]); w.w = pk2(o[6], o[7]);
            *(u32x4*)((bf16_t*)(ws + OFF_WINT) + (size_t)(12 * 256 + prow) * 1024 + 8 * kc) = w;
        }
    }
}

DI void p0_caches(const Params& p, LAS unsigned char* lds, int rank, int nblk) {
    int tid = threadIdx.x; asm volatile("" : "+v"(tid));
    const int lane = tid & 63, wid = __builtin_amdgcn_readfirstlane(tid >> 6);
    const int gw = rank * 8 + wid, NGW = nblk * 8;
    unsigned char* ws = p.ws;
    LAS float* scr = (LAS float*)(lds + wid * 8448);
    for (int it = gw; it < 4096 + 1024; it += NGW) {
        if (it < 4096) {
            const int sb = it >> 7, rem = it & 127, ng = rem >> 3, kb = rem & 7;
            transpose_item(p.cache_a_v + (size_t)sb * 262144 + (size_t)(64 * kb) * 512 + 32 * ng, 512, (bf16_t*)(ws + OFF_VST) + (size_t)(sb * 512 + 32 * ng) * 528 + 64 * kb, 528, scr, lane);
        } else {
            const int j = it - 4096, sb = j >> 5, rem = j & 31, ng = rem >> 2, kb = rem & 3;
            transpose_item(p.cache_mem_v + (size_t)sb * 65536 + (size_t)(64 * kb) * 256 + 32 * ng, 256, (bf16_t*)(ws + OFF_MVST) + (size_t)(sb * 256 + 32 * ng) * 256 + 64 * kb, 256, scr, lane);
        }
    }
    const int gt = rank * 512 + tid, NGT = nblk * 512;
    for (int e0 = gt; e0 < 1048576; e0 += 4 * NGT) {
        f32x4 a[4][2];
#pragma unroll
        for (int q = 0; q < 4; ++q) { const int e = e0 + q * NGT; if (e < 1048576) { const f32x4* sp = (const f32x4*)(p.cache_a_k + (size_t)e * 8); a[q][0] = sp[0]; a[q][1] = sp[1]; } }
#pragma unroll
        for (int q = 0; q < 4; ++q) { const int e = e0 + q * NGT; if (e < 1048576) *(u32x4*)((bf16_t*)(ws + OFF_KS) + (size_t)(e >> 15) * 528 * 512 + (size_t)(e & 32767) * 8) = pack8(a[q][0], a[q][1]); }
    }
    for (int e0 = gt; e0 < 262144; e0 += 2 * NGT) {
        f32x4 a[2][2];
#pragma unroll
        for (int q = 0; q < 2; ++q) { const int e = e0 + q * NGT; if (e < 262144) { const f32x4* sp = (const f32x4*)(p.cache_mem_k + (size_t)e * 8); a[q][0] = sp[0]; a[q][1] = sp[1]; } }
#pragma unroll
        for (int q = 0; q < 2; ++q) { const int e = e0 + q * NGT; if (e < 262144) *(u32x4*)((bf16_t*)(ws + OFF_MKS) + (size_t)e * 8) = pack8(a[q][0], a[q][1]); }
    }
}

struct AttnItem { const bf16_t* q; int qld; int nq; const bf16_t* k; int kld; const bf16_t* vt; int vtld; int nkb; int nkeys; const LAS float* bias; int qpos0; bf16_t* zo; int zold; };

DI void attn_block(const AttnItem& it, int key0, int qi, int hh, const bf16x8 (&bq)[4], LAS unsigned char* Kl, LAS unsigned char* Vl, unsigned kr, unsigned vr,
                   float& mrun, float& lsum, f32x16& o0, f32x16& o1) {
    f32x16 s;
#pragma unroll
    for (int r = 0; r < 16; ++r) s[r] = 0.f;
    bf16x8 akf[4];
#pragma unroll
    for (int kk = 0; kk < 4; ++kk) akf[kk] = *(const LAS bf16x8*)(Kl + kr + kk * 32);
    __builtin_amdgcn_sched_barrier(0);
#pragma unroll
    for (int kk = 0; kk < 4; ++kk) s = MFMA32(akf[kk], bq[kk], s);
    u32x2 vfr[2][2][2];
#pragma unroll
    for (int ks = 0; ks < 2; ++ks) {
        vfr[0][ks][0] = *(const LAS u32x2*)(Vl + vr + ks * 32); vfr[0][ks][1] = *(const LAS u32x2*)(Vl + vr + ks * 32 + 16);
        vfr[1][ks][0] = *(const LAS u32x2*)(Vl + vr + 2560 + ks * 32); vfr[1][ks][1] = *(const LAS u32x2*)(Vl + vr + 2560 + ks * 32 + 16);
    }
    __builtin_amdgcn_sched_barrier(0);
    if (it.bias) {
        const int d0 = it.qpos0 - key0;
        if (d0 - 31 >= 128) {
            const float bc = it.bias[256];
#pragma unroll
            for (int r = 0; r < 16; ++r) s[r] += bc;
        } else {
#pragma unroll
            for (int r = 0; r < 16; ++r) {
                int d = d0 + qi - ((r & 3) + 8 * (r >> 2) + 4 * hh);
                d = d < -128 ? -128 : (d > 128 ? 128 : d);
                s[r] += it.bias[d + 128];
            }
        }
    }
    if (key0 + 32 > it.nkeys) {
#pragma unroll
        for (int r = 0; r < 16; ++r) if (key0 + (r & 3) + 8 * (r >> 2) + 4 * hh >= it.nkeys) s[r] = -1e30f;
    }
    float mx = s[0];
#pragma unroll
    for (int r = 1; r < 16; ++r) mx = fmaxf(mx, s[r]);
    mx = fmaxf(mx, __shfl_xor(mx, 32));
    const float mnew = fmaxf(mrun, mx);
    const float alpha = __builtin_amdgcn_exp2f(mrun - mnew);
    mrun = mnew;
    float rs = 0.f;
#pragma unroll
    for (int r = 0; r < 16; ++r) { s[r] = __builtin_amdgcn_exp2f(s[r] - mnew); rs += s[r]; }
    lsum = lsum * alpha + rs;
#pragma unroll
    for (int r = 0; r < 16; ++r) { o0[r] *= alpha; o1[r] *= alpha; }
#pragma unroll
    for (int ks = 0; ks < 2; ++ks) {
        u32x4 pw; pw.x = pk2(s[8 * ks], s[8 * ks + 1]); pw.y = pk2(s[8 * ks + 2], s[8 * ks + 3]); pw.z = pk2(s[8 * ks + 4], s[8 * ks + 5]); pw.w = pk2(s[8 * ks + 6], s[8 * ks + 7]);
        const bf16x8 pb = __builtin_bit_cast(bf16x8, pw);
        const u32x2 a00 = vfr[0][ks][0], a01 = vfr[0][ks][1];
        const u32x2 a10 = vfr[1][ks][0], a11 = vfr[1][ks][1];
        u32x4 a0; a0.x = a00.x; a0.y = a00.y; a0.z = a01.x; a0.w = a01.y;
        u32x4 a1; a1.x = a10.x; a1.y = a10.y; a1.z = a11.x; a1.w = a11.y;
        o0 = MFMA32(__builtin_bit_cast(bf16x8, a0), pb, o0);
        o1 = MFMA32(__builtin_bit_cast(bf16x8, a1), pb, o1);
    }
}

DI void attn_item(const AttnItem& it, LAS unsigned char* wl, int lane) {
    const int qi = lane & 31, hh = lane >> 5;
    const int qr = qi < it.nq ? qi : it.nq - 1;
    bf16x8 bq[4];
#pragma unroll
    for (int kk = 0; kk < 4; ++kk) bq[kk] = *(const bf16x8*)(it.q + (size_t)qr * it.qld + 16 * kk + 8 * hh);
    float mrun = -1e30f, lsum = 0.f;
    f32x16 o0, o1;
#pragma unroll
    for (int r = 0; r < 16; ++r) { o0[r] = 0.f; o1[r] = 0.f; }
    const int krow = lane >> 3, kch = lane & 7, vrow = lane >> 2, vch = lane & 3;
    const bf16_t* kg = it.k + (size_t)krow * it.kld + 8 * kch;
    const bf16_t* vg = it.vt + (size_t)vrow * it.vtld + 8 * vch;
    LAS unsigned char* Kl = wl; LAS unsigned char* Vl = wl + 4608;
    const unsigned kw = krow * 144 + kch * 16, vw = vrow * 80 + vch * 16;
    const unsigned kr = qi * 144 + hh * 16, vr = qi * 80 + hh * 8;
    u32x4 kA[4], vA[4], kB[4], vB[4];
#define ATT_LOAD(KR, VR, kb_) do { _Pragma("unroll") for (int i = 0; i < 4; ++i) { KR[i] = *(const u32x4*)(kg + (size_t)(32 * (kb_) + 8 * i) * it.kld); VR[i] = *(const u32x4*)(vg + (size_t)(16 * i) * it.vtld + 32 * (kb_)); } } while (0)
#define ATT_STORE(KR, VR) do { _Pragma("unroll") for (int i = 0; i < 4; ++i) { *(LAS u32x4*)(Kl + kw + i * 1152) = KR[i]; *(LAS u32x4*)(Vl + vw + i * 1280) = VR[i]; } } while (0)
    ATT_LOAD(kA, vA, 0);
    if (it.nkb > 1) ATT_LOAD(kB, vB, 1);
    for (int kb = 0; kb < it.nkb; kb += 2) {
        ATT_STORE(kA, vA);
        if (kb + 2 < it.nkb) ATT_LOAD(kA, vA, kb + 2);
        attn_block(it, 32 * kb, qi, hh, bq, Kl, Vl, kr, vr, mrun, lsum, o0, o1);
        if (kb + 1 < it.nkb) {
            ATT_STORE(kB, vB);
            if (kb + 3 < it.nkb) ATT_LOAD(kB, vB, kb + 3);
            attn_block(it, 32 * kb + 32, qi, hh, bq, Kl, Vl, kr, vr, mrun, lsum, o0, o1);
        }
    }
#undef ATT_LOAD
#undef ATT_STORE
    lsum += __shfl_xor(lsum, 32);
    const float inv = __fdividef(1.f, lsum);
    if (qi < it.nq) {
        bf16_t* zr = it.zo + (size_t)qi * it.zold + 4 * hh;
#pragma unroll
        for (int g = 0; g < 4; ++g) {
            { const u32x2 z = *(const u32x2*)(zr + 8 * g); u32x2 w;
              w.x = pk2(o0[4 * g] * inv * bflo(z.x), o0[4 * g + 1] * inv * bfhi(z.x)); w.y = pk2(o0[4 * g + 2] * inv * bflo(z.y), o0[4 * g + 3] * inv * bfhi(z.y));
              *(u32x2*)(zr + 8 * g) = w; }
            { const u32x2 z = *(const u32x2*)(zr + 32 + 8 * g); u32x2 w;
              w.x = pk2(o1[4 * g] * inv * bflo(z.x), o1[4 * g + 1] * inv * bfhi(z.x)); w.y = pk2(o1[4 * g + 2] * inv * bflo(z.y), o1[4 * g + 3] * inv * bfhi(z.y));
              *(u32x2*)(zr + 32 + 8 * g) = w; }
        }
    }
    LDS_WAIT();
}

DI void gla_local(const Params& p, int item, LAS unsigned char* wl, int lane) {
    unsigned char* ws = p.ws;
    const int c = item & 127, bh = item >> 7, h = bh & 3, b = bh >> 2;
    const int t0 = b * 8192 + 64 * c;
    const float* la = (const float*)(ws + OFF_LOGA) + (size_t)t0 * 256 + h * 64 + lane;
    const bf16_t* kb = (const bf16_t*)(ws + OFF_KB) + (size_t)t0 * 256 + h * 64 + lane;
    float lav[64]; bf16_t kvv[64];
#pragma unroll
    for (int t = 0; t < 64; ++t) { lav[t] = la[t * 256]; kvv[t] = kb[t * 256]; }
    __builtin_amdgcn_sched_barrier(0);
    float tot = 0.f;
#pragma unroll
    for (int t = 0; t < 64; ++t) tot += lav[t];
    float cum = 0.f;
#pragma unroll
    for (int t = 0; t < 64; ++t) {
        cum += lav[t];
        const float kh = bf2f(kvv[t]) * __expf(tot - cum);
        *(LAS bf16_t*)(wl + lane * 144 + 2 * t) = f2bf(kh);
    }
    ((float*)(ws + OFF_DEC))[item * 64 + lane] = __expf(tot);
    LDS_WAIT();
    const int qi = lane & 31, hh = lane >> 5;
    bf16x8 bk[2][4];
#pragma unroll
    for (int dkb = 0; dkb < 2; ++dkb)
#pragma unroll
        for (int ks = 0; ks < 4; ++ks) bk[dkb][ks] = *(const LAS bf16x8*)(wl + (32 * dkb + qi) * 144 + (16 * ks + 8 * hh) * 2);
    float* so = p.out + O_Y + (size_t)item * 8192;
#pragma unroll 1
    for (int dvb = 0; dvb < 4; ++dvb) {
        const bf16_t* vrow = (const bf16_t*)(ws + OFF_VBT) + (size_t)item * 8192 + (size_t)((dvb * 8 + hh) * 32 + qi) * 8;
        f32x16 a0, a1;
#pragma unroll
        for (int r = 0; r < 16; ++r) { a0[r] = 0.f; a1[r] = 0.f; }
        bf16x8 av[4];
#pragma unroll
        for (int ks = 0; ks < 4; ++ks) av[ks] = *(const bf16x8*)(vrow + 512 * ks);
        __builtin_amdgcn_sched_barrier(0);
#pragma unroll
        for (int ks = 0; ks < 4; ++ks) { a0 = MFMA32(av[ks], bk[0][ks], a0); a1 = MFMA32(av[ks], bk[1][ks], a1); }
#pragma unroll
        for (int r = 0; r < 16; ++r) { const int dv = 32 * dvb + (r & 3) + 8 * (r >> 2) + 4 * hh; so[dv * 64 + qi] = a0[r]; so[dv * 64 + 32 + qi] = a1[r]; }
    }
    LDS_WAIT();
}

template <bool SAMPLE>
DI void gla_out(const Params& p, int item, int tbsel, LAS unsigned char* wl, int lane) {
    unsigned char* ws = p.ws;
    int b = 0, h, c = 0, t0, sb = 0;
    if (SAMPLE) { sb = item >> 2; h = item & 3; t0 = T_P + 16 * sb; }
    else { c = item & 127; const int bh = item >> 7; h = bh & 3; b = bh >> 2; t0 = b * 8192 + 64 * c; }
    const float* la = (const float*)(ws + OFF_LOGA) + (size_t)t0 * 256 + h * 64 + lane;
    const bf16_t* qb = (const bf16_t*)(ws + OFF_QB) + (size_t)t0 * 256 + h * 64 + lane;
    const bf16_t* kb = (const bf16_t*)(ws + OFF_KB) + (size_t)t0 * 256 + h * 64 + lane;
    LAS unsigned char* Qs = wl; LAS unsigned char* Ks = wl + 9216;
    float cum = 0.f;
    constexpr int HB = SAMPLE ? 16 : 32;
    const int tb = SAMPLE ? 0 : tbsel;
    const int nhalf = SAMPLE ? 1 : tb + 1;
#pragma unroll 1
    for (int hf = 0; hf < nhalf; ++hf) {
        float lav[HB]; bf16_t qvv[HB], kvv[HB];
#pragma unroll
        for (int t = 0; t < HB; ++t) { lav[t] = la[(hf * 32 + t) * 256]; qvv[t] = qb[(hf * 32 + t) * 256]; kvv[t] = kb[(hf * 32 + t) * 256]; }
#pragma unroll
        for (int t = 0; t < HB; ++t) {
            cum += lav[t];
            const float qv = bf2f(qvv[t]) * __expf(cum), kv = bf2f(kvv[t]) * __expf(-cum);
            *(LAS bf16_t*)(Qs + (hf * 32 + t) * 144 + 2 * lane) = f2bf(qv);
            *(LAS bf16_t*)(Ks + (hf * 32 + t) * 144 + 2 * lane) = f2bf(kv);
        }
    }
    if (SAMPLE) {
#pragma unroll
        for (int t = 16; t < 32; ++t) { *(LAS bf16_t*)(Qs + t * 144 + 2 * lane) = 0; *(LAS bf16_t*)(Ks + t * 144 + 2 * lane) = 0; }
    }
    const float tot = cum;
    const int qi = lane & 31, hh = lane >> 5;
    bf16x8 sa[4][4]; u32x2 vf[2][2][4][2];
    if (!SAMPLE) {
#pragma unroll
        for (int dvb = 0; dvb < 4; ++dvb)
#pragma unroll
            for (int kk = 0; kk < 4; ++kk) sa[dvb][kk] = *(const bf16x8*)((const bf16_t*)(p.out + O_SPB) + (size_t)item * 8192 + (size_t)(((dvb * 4 + kk) * 2 + hh) * 32 + qi) * 8);
#pragma unroll
        for (int sbk = 0; sbk < 2; ++sbk) if (sbk <= tb) {
#pragma unroll
            for (int ks = 0; ks < 2; ++ks)
#pragma unroll
                for (int dvb = 0; dvb < 4; ++dvb) {
                    const bf16_t* vp = (const bf16_t*)(ws + OFF_VBT) + (size_t)item * 8192 + (size_t)((dvb * 8 + 4 * sbk + 2 * ks) * 32 + qi) * 8 + 4 * hh;
                    vf[sbk][ks][dvb][0] = *(const u32x2*)vp; vf[sbk][ks][dvb][1] = *(const u32x2*)(vp + 256);
                }
        }
        __builtin_amdgcn_sched_barrier(0);
    }
    LDS_WAIT();
    {
        bf16x8 bq[4];
#pragma unroll
        for (int kk = 0; kk < 4; ++kk) bq[kk] = *(const LAS bf16x8*)(Qs + (32 * tb + qi) * 144 + (16 * kk + 8 * hh) * 2);
        f32x16 o[4];
#pragma unroll
        for (int dvb = 0; dvb < 4; ++dvb)
#pragma unroll
            for (int r = 0; r < 16; ++r) o[dvb][r] = 0.f;
#pragma unroll
        for (int dvb = 0; dvb < 4; ++dvb)
#pragma unroll
            for (int kk = 0; kk < 4; ++kk) {
                bf16x8 a;
                if (!SAMPLE) {
                    a = sa[dvb][kk];
                } else {
                    const float* sp = p.state_gla + (size_t)item * 8192 + (size_t)(16 * kk + 8 * hh) * 128 + 32 * dvb + qi;
                    u32x4 w; w.x = pk2(sp[0], sp[128]); w.y = pk2(sp[256], sp[384]); w.z = pk2(sp[512], sp[640]); w.w = pk2(sp[768], sp[896]);
                    a = __builtin_bit_cast(bf16x8, w);
                }
                o[dvb] = MFMA32(a, bq[kk], o[dvb]);
                if (SAMPLE) asm volatile("" ::: "memory");
            }
#pragma unroll
        for (int sbk = 0; sbk < (SAMPLE ? 1 : 2); ++sbk) if (sbk <= tb) {
            f32x16 st;
#pragma unroll
            for (int r = 0; r < 16; ++r) st[r] = 0.f;
#pragma unroll
            for (int kk = 0; kk < 4; ++kk) { const bf16x8 ak = *(const LAS bf16x8*)(Ks + (32 * sbk + qi) * 144 + (16 * kk + 8 * hh) * 2); st = MFMA32(ak, bq[kk], st); }
            if (sbk == tb) {
#pragma unroll
                for (int r = 0; r < 16; ++r) if ((r & 3) + 8 * (r >> 2) + 4 * hh > qi) st[r] = 0.f;
            }
#pragma unroll
            for (int ks = 0; ks < (SAMPLE ? 1 : 2); ++ks) {
                u32x4 pw; pw.x = pk2(st[8 * ks], st[8 * ks + 1]); pw.y = pk2(st[8 * ks + 2], st[8 * ks + 3]); pw.z = pk2(st[8 * ks + 4], st[8 * ks + 5]); pw.w = pk2(st[8 * ks + 6], st[8 * ks + 7]);
                const bf16x8 pb = __builtin_bit_cast(bf16x8, pw);
#pragma unroll
                for (int dvb = 0; dvb < 4; ++dvb) {
                    u32x2 v0, v1;
                    if (SAMPLE) { const bf16_t* vp = (const bf16_t*)(ws + OFF_VBTS) + (size_t)(sb * 512 + h * 128 + 32 * dvb + qi) * 16 + 4 * hh; v0 = *(const u32x2*)vp; v1 = *(const u32x2*)(vp + 8); }
                    else { v0 = vf[sbk][ks][dvb][0]; v1 = vf[sbk][ks][dvb][1]; }
                    u32x4 aw; aw.x = v0.x; aw.y = v0.y; aw.z = v1.x; aw.w = v1.y;
                    o[dvb] = MFMA32(__builtin_bit_cast(bf16x8, aw), pb, o[dvb]);
                }
            }
        }
        float ss = 0.f;
#pragma unroll
        for (int dvb = 0; dvb < 4; ++dvb)
#pragma unroll
            for (int r = 0; r < 16; ++r) ss += o[dvb][r] * o[dvb][r];
        ss += __shfl_xor(ss, 32);
        const float rstd = rsqrtf(ss * (1.f / 128.f) + EPS);
        int lz = 0; asm volatile("" : "+v"(lz));
        if (!SAMPLE || qi < 16) {
            bf16_t* zr = (bf16_t*)(ws + OFF_ZB) + (size_t)(t0 + 32 * tb + qi) * 512 + h * 128 + 4 * hh;
#pragma unroll
            for (int dvb = 0; dvb < 4; ++dvb)
#pragma unroll
                for (int g = 0; g < 4; ++g) {
                    const int dv = 32 * dvb + 8 * g;
                    const f32x4 gg = *(const f32x4*)(p.g_gla_out + dv + 4 * hh + lz);
                    const u32x2 z = *(const u32x2*)(zr + dv); u32x2 w;
                    w.x = pk2(o[dvb][4 * g] * rstd * gg[0] * bflo(z.x), o[dvb][4 * g + 1] * rstd * gg[1] * bfhi(z.x));
                    w.y = pk2(o[dvb][4 * g + 2] * rstd * gg[2] * bflo(z.y), o[dvb][4 * g + 3] * rstd * gg[3] * bfhi(z.y));
                    *(u32x2*)(zr + dv) = w;
                }
        }
    }
    if (SAMPLE) {
        LDS_WAIT();
        float cum2 = 0.f;
#pragma unroll
        for (int t = 0; t < 16; ++t) {
            cum2 += la[t * 256];
            *(LAS bf16_t*)(Qs + lane * 144 + 2 * t) = f2bf(bf2f(kb[t * 256]) * __expf(tot - cum2));
        }
        ((LAS float*)Ks)[lane] = __expf(tot);
        LDS_WAIT();
#pragma unroll
        for (int dkb = 0; dkb < 2; ++dkb) {
            const bf16x8 ak = *(const LAS bf16x8*)(Qs + (32 * dkb + qi) * 144 + 8 * hh * 2);
#pragma unroll
            for (int dvb = 0; dvb < 4; ++dvb) {
                const bf16x8 bv = *(const bf16x8*)((const bf16_t*)(ws + OFF_VBTS) + (size_t)(sb * 512 + h * 128 + 32 * dvb + qi) * 16 + 8 * hh);
                f32x16 sl;
#pragma unroll
                for (int r = 0; r < 16; ++r) sl[r] = 0.f;
                sl = MFMA32(ak, bv, sl);
#pragma unroll
                for (int r = 0; r < 16; ++r) {
                    const int dk = 32 * dkb + (r & 3) + 8 * (r >> 2) + 4 * hh;
                    const size_t idx = (size_t)item * 8192 + (size_t)dk * 128 + 32 * dvb + qi;
                    p.out[O_GLS + idx] = p.state_gla[idx] * ((const LAS float*)Ks)[dk] + sl[r];
                }
            }
        }
    }
    LDS_WAIT();
}

DI void p2_mixers(const Params& p, LAS unsigned char* lds) {
    int tid = threadIdx.x; asm volatile("" : "+v"(tid));
    const int lane = tid & 63, wid = __builtin_amdgcn_readfirstlane(tid >> 6);
    unsigned char* ws = p.ws;
    LAS float* tab = (LAS float*)lds;
    for (int i = tid; i < 8 * 257; i += 512) tab[i] = p.rel_bias[i] * LOG2E;
    __syncthreads();
    LAS unsigned char* wl = lds + LDS_TAB + wid * LDS_WAVE;
    const int G = gridDim.x, gw = wid * G + blockIdx.x, NGW = G * 8;
    for (int it = gw, stage2 = 0;; it += NGW) {
        if (!stage2 && it >= 4096) { stage2 = 1; it = 4096 + gw; }
        if (stage2 && it >= 4352) break;
        AttnItem a;
        a.qld = 512; a.kld = 512; a.zold = 512;
        if (it < 4096) {
            const int head = it & 7, half = (it >> 3) & 1, c = (it >> 4) & 127, b = it >> 11;
            const int cs = c > 8 ? c - 8 : 0, kstart = 64 * cs, tq = b * 8192 + 64 * c + 32 * half;
            a.q = (const bf16_t*)(ws + OFF_QA) + (size_t)tq * 512 + head * 64; a.nq = 32;
            a.k = (const bf16_t*)(ws + OFF_KA) + (size_t)(b * 8192 + kstart) * 512 + head * 64;
            a.vt = (const bf16_t*)(ws + OFF_VAT) + (size_t)(b * 512 + head * 64) * VLD + kstart; a.vtld = VLD;
            a.nkeys = 64 * (c - cs + 1); a.nkb = a.nkeys >> 5;
            a.bias = tab + head * 257; a.qpos0 = 64 * c + 32 * half - kstart;
            a.zo = (bf16_t*)(ws + OFF_ZA) + (size_t)tq * 512 + head * 64;
        } else {
            const int j = it - 4096, head = j & 7, sb = j >> 3, tq = T_P + 16 * sb;
            a.q = (const bf16_t*)(ws + OFF_QA) + (size_t)tq * 512 + head * 64; a.nq = 16;
            a.k = (const bf16_t*)(ws + OFF_KS) + (size_t)sb * 528 * 512 + head * 64;
            a.vt = (const bf16_t*)(ws + OFF_VST) + (size_t)(sb * 512 + head * 64) * 528; a.vtld = 528;
            a.nkeys = 528; a.nkb = 17;
            a.bias = tab + head * 257; a.qpos0 = 512;
            a.zo = (bf16_t*)(ws + OFF_ZA) + (size_t)tq * 512 + head * 64;
        }
        attn_item(a, wl, lane);
    }
    {
        int m0 = -1, m1 = -1;
        if (NGW == 2048) { if (gw >= 256) m0 = gw - 256; if (gw >= 1536 && gw < 1792) m1 = gw + 256; if (gw >= 256 && gw < 384) m1 = 2048 + gw - 256; }
        for (int k = 0;; ++k) {
            int it;
            if (NGW == 2048) { if (k >= 2) break; it = k ? m1 : m0; if (it < 0) continue; }
            else { it = gw + k * NGW; if (it >= 2176) break; }
            AttnItem a;
            a.qld = 256; a.kld = 256; a.zold = 256; a.vtld = 256; a.nkeys = 256; a.nkb = 8; a.bias = nullptr; a.qpos0 = 0;
            if (it < 2048) {
                const int head = it & 3, tg = it >> 2, tq = 32 * tg, b = tq >> 13;
                a.q = (const bf16_t*)(ws + OFF_QM) + (size_t)tq * 256 + head * 64; a.nq = 32;
                a.k = (const bf16_t*)(ws + OFF_MK) + (size_t)b * 65536 + head * 64;
                a.vt = (const bf16_t*)(ws + OFF_MVT) + (size_t)(b * 256 + head * 64) * 256;
                a.zo = (bf16_t*)(ws + OFF_ZM) + (size_t)tq * 256 + head * 64;
            } else {
                const int j = it - 2048, head = j & 3, sb = j >> 2, tq = T_P + 16 * sb;
                a.q = (const bf16_t*)(ws + OFF_QM) + (size_t)tq * 256 + head * 64; a.nq = 16;
                a.k = (const bf16_t*)(ws + OFF_MKS) + (size_t)sb * 65536 + head * 64;
                a.vt = (const bf16_t*)(ws + OFF_MVST) + (size_t)(sb * 256 + head * 64) * 256;
                a.zo = (bf16_t*)(ws + OFF_ZM) + (size_t)tq * 256 + head * 64;
            }
            attn_item(a, wl, lane);
        }
    }
    { int s0 = gw - 384; if (s0 < 0) s0 += NGW; for (int it = s0; it < 1024; it += NGW) gla_local(p, ((it & 7) << 7) | (it >> 3), wl, lane); }
    { int s0 = gw - 1408; if (s0 < 0) s0 += NGW; for (int it = s0; it < 128; it += NGW) gla_out<true>(p, it, 0, wl, lane); }
}

DI int wt_row(int nb) { const int t = nb >> 3, q = nb & 7; return t * 256 + 128 * (q & 1) + 32 * (q >> 1); }
DI void sample_up_item(const Params& p, int item, int lane) {
    unsigned char* ws = p.ws;
    const int qi = lane & 31, hh = lane >> 5, tg = item >> 5, nb = item & 31;
    const int tok = T_P + 32 * tg + qi, wrow = wt_row(nb) + qi;
    f32x16 tot;
#pragma unroll
    for (int r = 0; r < 16; ++r) tot[r] = 0.f;
#pragma unroll
    for (int br = 0; br < 3; ++br) {
        const int ld = br == 2 ? 256 : 512;
        const bf16_t* gp = (const bf16_t*)(ws + (br == 0 ? OFF_ZA : (br == 1 ? OFF_ZB : OFF_ZM))) + (size_t)tok * ld + 8 * hh;
        const bf16_t* wp = (const bf16_t*)(ws + (br == 0 ? OFF_WUPA : (br == 1 ? OFF_WUPB : OFF_WUPM))) + (size_t)wrow * ld + 8 * hh;
        f32x16 acc;
#pragma unroll
        for (int r = 0; r < 16; ++r) acc[r] = 0.f;
#pragma unroll 1
        for (int c0 = 0; c0 < ld / 16; c0 += 16) {
            bf16x8 wa[16], ga[16];
#pragma unroll
            for (int j = 0; j < 16; ++j) { wa[j] = *(const bf16x8*)(wp + 16 * (c0 + j)); ga[j] = *(const bf16x8*)(gp + 16 * (c0 + j)); }
            __builtin_amdgcn_sched_barrier(0);
#pragma unroll
            for (int j = 0; j < 16; ++j) acc = MFMA32(wa[j], ga[j], acc);
            __builtin_amdgcn_sched_barrier(0);
        }
        const bf16_t* sg = (const bf16_t*)(ws + OFF_SGS) + (size_t)(tok - T_P) * 3072 + br * 1024 + 32 * nb + 4 * hh;
#pragma unroll
        for (int g = 0; g < 4; ++g) {
            const u32x2 z = *(const u32x2*)(sg + 8 * g);
            tot[4 * g] += acc[4 * g] * bflo(z.x); tot[4 * g + 1] += acc[4 * g + 1] * bfhi(z.x); tot[4 * g + 2] += acc[4 * g + 2] * bflo(z.y); tot[4 * g + 3] += acc[4 * g + 3] * bfhi(z.y);
        }
    }
    bf16_t* up = (bf16_t*)(ws + OFF_UB) + (size_t)tok * 1024 + 32 * nb + 4 * hh;
#pragma unroll
    for (int g = 0; g < 4; ++g) { u32x2 w; w.x = pk2(tot[4 * g], tot[4 * g + 1]); w.y = pk2(tot[4 * g + 2], tot[4 * g + 3]); *(u32x2*)(up + 8 * g) = w; }
}
DI void sample_out_item(const Params& p, int item, int lane) {
    unsigned char* ws = p.ws;
    const int qi = lane & 31, hh = lane >> 5, tg = item >> 5, nb = item & 31;
    const int tok = T_P + 32 * tg + qi, wrow = wt_row(nb) + qi;
    const bf16_t* up = (const bf16_t*)(ws + OFF_UB) + (size_t)tok * 1024 + 8 * hh;
    const bf16_t* wp = (const bf16_t*)(ws + OFF_WOUT) + (size_t)wrow * 1024 + 8 * hh;
    f32x16 acc;
#pragma unroll
    for (int r = 0; r < 16; ++r) acc[r] = 0.f;
#pragma unroll 1
    for (int c0 = 0; c0 < 64; c0 += 16) {
        bf16x8 wa[16], ga[16];
#pragma unroll
        for (int j = 0; j < 16; ++j) { wa[j] = *(const bf16x8*)(wp + 16 * (c0 + j)); ga[j] = *(const bf16x8*)(up + 16 * (c0 + j)); }
        __builtin_amdgcn_sched_barrier(0);
#pragma unroll
        for (int j = 0; j < 16; ++j) acc = MFMA32(wa[j], ga[j], acc);
        __builtin_amdgcn_sched_barrier(0);
    }
    const float* xr = p.x_sample + (size_t)(tok - T_P) * 1024 + 32 * nb + 4 * hh;
    float* yr = p.out + O_Y + (size_t)tok * 1024 + 32 * nb + 4 * hh;
#pragma unroll
    for (int g = 0; g < 4; ++g) { const f32x4 x = *(const f32x4*)(xr + 8 * g); f32x4 y; y[0] = x[0] + acc[4 * g]; y[1] = x[1] + acc[4 * g + 1]; y[2] = x[2] + acc[4 * g + 2]; y[3] = x[3] + acc[4 * g + 3]; *(f32x4*)(yr + 8 * g) = y; }
}

DI void p3_scan(const Params& p) {
    int tid = threadIdx.x; asm volatile("" : "+v"(tid));
    const int lane = tid & 63, wid = __builtin_amdgcn_readfirstlane(tid >> 6);
    const int G = gridDim.x, gw = wid * G + blockIdx.x, NGW = G * 8;
    const float* dec = (const float*)(p.ws + OFF_DEC);
    for (int w = gw; w < 1024; w += NGW) {
        const int bh = w & 7, idx = (w >> 3) * 64 + lane, dk = idx & 63, dv = idx >> 6;
        const float* sl = p.out + O_Y + (size_t)bh * 128 * 8192 + idx;
        bf16_t* sp = (bf16_t*)(p.out + O_SPB) + (size_t)bh * 128 * 8192 + (size_t)((((dv >> 5) * 4 + (dk >> 4)) * 2 + ((dk >> 3) & 1)) * 32 + (dv & 31)) * 8 + (dk & 7);
        const float* dc = dec + (size_t)bh * 128 * 64 + dk;
        float S = 0.f;
        for (int c0 = 0; c0 < 128; c0 += 32) {
            float v[32], d[32];
#pragma unroll
            for (int j = 0; j < 32; ++j) { v[j] = sl[(size_t)(c0 + j) * 8192]; d[j] = dc[(c0 + j) * 64]; }
            __builtin_amdgcn_sched_barrier(0);
#pragma unroll
            for (int j = 0; j < 32; ++j) { sp[(size_t)(c0 + j) * 8192] = f2bf(S); S = S * d[j] + v[j]; }
        }
        p.out[O_GLP + (size_t)bh * 8192 + dk * 128 + dv] = S;
    }
    { int s0 = gw - 1024; if (s0 < 0) s0 += NGW; for (int it = s0; it < 512; it += NGW) sample_up_item(p, it, lane); }
}

DI void p4_gla_out(const Params& p, LAS unsigned char* lds) {
    int tid = threadIdx.x; asm volatile("" : "+v"(tid));
    const int lane = tid & 63, wid = __builtin_amdgcn_readfirstlane(tid >> 6);
    LAS unsigned char* wl = lds + LDS_TAB + wid * LDS_WAVE;
    const int G = gridDim.x, gw = wid * G + blockIdx.x, NGW = G * 8;
    for (int it = gw; it < 2048; it += NGW) gla_out<false>(p, ((it & 7) << 7) | (it >> 4), (it >> 3) & 1, wl, lane);
    if (((gw >> 3) & 1) == 0) for (int it = ((gw >> 4) << 3) | (gw & 7); it < 512; it += NGW >> 1) sample_out_item(p, it, lane);
}

#define XB_TMO      128
#define XB_XCNT(j)  (256  + 64 * (j))
#define XB_XSUB(j)  (1280 + 64 * (j))
#define XB_XGEN(j)  (2304 + 64 * (j))
#define XB_TOP      3328
#define XB_TOPGEN   3392
#define XCD_BAR_WORDS 3456
#define XB_SPIN_CAP (1u << 18)
DI unsigned xb_ld(unsigned* p)              { return __hip_atomic_load(p, __ATOMIC_RELAXED, __HIP_MEMORY_SCOPE_AGENT); }
DI unsigned xb_add(unsigned* p, unsigned v) { return __hip_atomic_fetch_add(p, v, __ATOMIC_RELAXED, __HIP_MEMORY_SCOPE_AGENT); }
DI unsigned xb_xcc_id() { return (unsigned)__builtin_amdgcn_s_getreg((3 << 11) | 20) & 0xFu; }
#define XB_SPIN(cond, bar) do { unsigned _sp = 0; while (cond) { __builtin_amdgcn_s_sleep(1); \
    if ((++_sp & 255u) == 0u) { if (xb_ld(&(bar)[XB_TMO])) break; if (_sp > XB_SPIN_CAP) { atomicAdd(&(bar)[XB_TMO], 1u); break; } } } } while (0)
struct XcdBarrier { unsigned* bar; unsigned x; volatile LAS unsigned* st; };
DI XcdBarrier xcd_barrier_post(unsigned* bar, volatile LAS unsigned* st) {
    XcdBarrier b; b.bar = bar; b.x = xb_xcc_id(); b.st = st;
    if (threadIdx.x == 0) (void)xb_add(&bar[XB_XCNT(b.x)], 1u);
    return b;
}
DI void xcd_barrier_complete(unsigned* bar, unsigned x, unsigned& nloc, unsigned& nx) {
    const unsigned G = gridDim.x * gridDim.y * gridDim.z;
    unsigned sum, cnt, mine, sp = 0u;
    for (;;) {
        sum = 0u; cnt = 0u; mine = 0u;
#pragma unroll
        for (unsigned j = 0; j < 16; ++j) { const unsigned c = xb_ld(&bar[XB_XCNT(j)]); sum += c; cnt += (c > 0u) ? 1u : 0u; mine = (j == x) ? c : mine; }
        if (sum == G) break;
        __builtin_amdgcn_s_sleep(1);
        if ((++sp & 255u) == 0u) { if (xb_ld(&bar[XB_TMO])) break; if (sp > XB_SPIN_CAP) { atomicAdd(&bar[XB_TMO], 1u); break; } }
    }
    nloc = mine > 0u ? mine : 1u; nx = cnt > 0u ? cnt : 1u;
}
DI void xcd_barrier(const XcdBarrier& b) {
    asm volatile("s_waitcnt vmcnt(0)" ::: "memory");
    __syncthreads();
    if (threadIdx.x == 0) {
        unsigned* bar = b.bar;
        __builtin_amdgcn_s_waitcnt(0);
        unsigned nloc = b.st[0], nx = b.st[1];
        if (nloc == 0u) { xcd_barrier_complete(bar, b.x, nloc, nx); b.st[0] = nloc; b.st[1] = nx; }
        const unsigned old = xb_add(&bar[XB_XSUB(b.x)], 1u);
        const unsigned gen = old / nloc;
        if (old + 1u == (gen + 1u) * nloc) {
            __builtin_amdgcn_fence(__ATOMIC_RELEASE, "agent");
            asm volatile("s_waitcnt vmcnt(0)" ::: "memory");
            const unsigned og = xb_add(&bar[XB_TOP], 1u);
            const unsigned tg = og / nx;
            if (og + 1u == (tg + 1u) * nx) xb_add(&bar[XB_TOPGEN], 1u);
            else XB_SPIN(xb_ld(&bar[XB_TOPGEN]) == tg, bar);
            __builtin_amdgcn_fence(__ATOMIC_ACQUIRE, "agent");
            xb_add(&bar[XB_XGEN(b.x)], 1u);
            asm volatile("s_waitcnt vmcnt(0)" ::: "memory");
        } else {
            XB_SPIN(xb_ld(&bar[XB_XGEN(b.x)]) == gen, bar);
            __builtin_amdgcn_fence(__ATOMIC_ACQUIRE, "agent");
            asm volatile("s_waitcnt vmcnt(0)" ::: "memory");
        }
    }
    __syncthreads();
}

__global__ void __launch_bounds__(512, 2) fwd_megakernel(Params p) {
    extern __shared__ __attribute__((aligned(16))) unsigned char lds_raw[];
    LAS unsigned char* lds = (LAS unsigned char*)lds_raw;
    if (threadIdx.x < 4) ((volatile LAS unsigned*)(lds + LDS_BAR))[threadIdx.x] = 0u;
    __syncthreads();
    const XcdBarrier bar = xcd_barrier_post((unsigned*)(p.ws + OFF_BAR), (volatile LAS unsigned*)(lds + LDS_BAR));
    if (p.ws == nullptr) cg::this_grid().sync();
    p0_prep(p, lds);
    xcd_barrier(bar);
    gemm_phase<1>(p, lds, 0);
    { const int nfull = (66 * 17 + 4 + 24) % (int)gridDim.x, nslack = (int)gridDim.x - nfull;
      if (nslack >= 32) { if ((int)blockIdx.x >= nfull) p0_caches(p, lds, (int)blockIdx.x - nfull, nslack); } else p0_caches(p, lds, (int)blockIdx.x, (int)gridDim.x); }
    xcd_barrier(bar);
    p2_mixers(p, lds);
    xcd_barrier(bar);
    p3_scan(p);
    xcd_barrier(bar);
    p4_gla_out(p, lds);
    xcd_barrier(bar);
    gemm_phase<5>(p, lds, 0);
    xcd_barrier(bar);
    gemm_phase<6>(p, lds, 0);
}

extern "C" void kernel_launch(void* const* d_in, const int* in_sizes, int n_in, void* d_out, int out_size, void* d_ws, size_t ws_size, hipStream_t stream) {
    static int grid_blocks = 0;
    if (grid_blocks == 0) {
        if (n_in != 24 || out_size != 20250624 || ws_size < WS_END) { fprintf(stderr, "kernel_launch: unexpected shapes (n_in %d out %d ws %zu)\n", n_in, out_size, ws_size); grid_blocks = -1; return; }
        int dev = 0, cus = 0, per_cu = 0;
        hipGetDevice(&dev);
        hipDeviceGetAttribute(&cus, hipDeviceAttributeMultiprocessorCount, dev);
        if (hipFuncSetAttribute((const void*)fwd_megakernel, hipFuncAttributeMaxDynamicSharedMemorySize, LDS_BYTES) != hipSuccess) { fprintf(stderr, "kernel_launch: hipFuncSetAttribute failed\n"); grid_blocks = -1; return; }
        if (hipOccupancyMaxActiveBlocksPerMultiprocessor(&per_cu, (const void*)fwd_megakernel, 512, LDS_BYTES) != hipSuccess || per_cu < 1) { fprintf(stderr, "kernel_launch: occupancy query failed (%d)\n", per_cu); (void)hipGetLastError(); grid_blocks = -1; return; }
        grid_blocks = cus * per_cu;
        if (grid_blocks > 256) grid_blocks = 256;
        if (grid_blocks < 16) { fprintf(stderr, "kernel_launch: grid of %d workgroups is too small for this kernel\n", grid_blocks); grid_blocks = -1; return; }
    }
    if (grid_blocks < 0) return;
    if (hipMemsetAsync((char*)d_ws + OFF_BAR, 0, 16384, stream) != hipSuccess) { fprintf(stderr, "kernel_launch: hipMemsetAsync failed\n"); return; }
    Params p{};
    const float** pp = (const float**)&p;
    for (int i = 0; i < 24; ++i) pp[i] = (const float*)d_in[i];
    p.out = (float*)d_out; p.ws = (unsigned char*)d_ws;
    void* args[] = {&p};
    hipError_t e = hipLaunchCooperativeKernel((const void*)fwd_megakernel, dim3(grid_blocks), dim3(512), args, LDS_BYTES, stream);
    if (e != hipSuccess) fprintf(stderr, "cooperative launch failed: %s (grid %d)\n", hipGetErrorString(e), grid_blocks);
}
```

```cpp
#include <hip/hip_runtime.h>
#include <hip/hip_cooperative_groups.h>
#include <cstdio>
#include <cstdint>
namespace cg = cooperative_groups;

#define LAS __attribute__((address_space(3)))
#define DI __device__ __forceinline__
typedef unsigned short bf16_t;
typedef short bf16x8 __attribute__((ext_vector_type(8)));
typedef float f32x2 __attribute__((ext_vector_type(2)));
typedef float f32x4 __attribute__((ext_vector_type(4)));
typedef float f32x16 __attribute__((ext_vector_type(16)));
typedef unsigned u32x2 __attribute__((ext_vector_type(2)));
typedef unsigned u32x4 __attribute__((ext_vector_type(4)));
typedef __bf16 bf2v __attribute__((ext_vector_type(2)));

DI unsigned pk2(float a, float b) { f32x2 v = {a, b}; bf2v r = __builtin_convertvector(v, bf2v); return __builtin_bit_cast(unsigned, r); }
DI bf16_t f2bf(float a) { return (bf16_t)(pk2(a, 0.f) & 0xffffu); }
DI float bf2f(bf16_t v) { return __uint_as_float(((unsigned)v) << 16); }
DI float bflo(unsigned w) { return __uint_as_float(w << 16); }
DI float bfhi(unsigned w) { return __uint_as_float(w & 0xffff0000u); }
DI u32x4 pack8(f32x4 a, f32x4 b) { u32x4 w; w.x = pk2(a[0], a[1]); w.y = pk2(a[2], a[3]); w.z = pk2(b[0], b[1]); w.w = pk2(b[2], b[3]); return w; }
#define MFMA32(a, b, c) __builtin_amdgcn_mfma_f32_32x32x16_bf16((a), (b), (c), 0, 0, 0)
#define LDS_WAIT() asm volatile("s_waitcnt lgkmcnt(0)" ::: "memory")

constexpr int T_P = 16384, T_ALL = 16896;
constexpr float EPS = 1e-6f;
constexpr float LOG2E = 1.4426950408889634f;
constexpr float QSCALE = 0.125f * LOG2E;

constexpr size_t OFF_WINT = 0;
constexpr size_t OFF_WUPA = OFF_WINT + 7424ull * 1024 * 2;
constexpr size_t OFF_WUPB = OFF_WUPA + 1024ull * 512 * 2;
constexpr size_t OFF_WUPM = OFF_WUPB + 1024ull * 512 * 2;
constexpr size_t OFF_WOUT = OFF_WUPM + 1024ull * 256 * 2;
constexpr size_t OFF_WMEM = OFF_WOUT + 1024ull * 1024 * 2;
constexpr size_t OFF_MEMH = OFF_WMEM + 512ull * 1024 * 2;
constexpr size_t OFF_H    = OFF_MEMH + 512ull * 1024 * 2;
constexpr size_t OFF_QA   = OFF_H + 16896ull * 1024 * 2;
constexpr size_t OFF_KA   = OFF_QA + 16896ull * 512 * 2;
constexpr size_t OFF_VAT  = OFF_KA + 16384ull * 512 * 2;
constexpr int VLD = 8320;
constexpr size_t OFF_KS   = OFF_VAT + 2ull * 512 * VLD * 2;
constexpr size_t OFF_VST  = OFF_KS + 32ull * 528 * 512 * 2 + 32768;
constexpr size_t OFF_ZA   = OFF_VST + 32ull * 512 * 528 * 2 + 32768;
constexpr size_t OFF_QB   = OFF_ZA + 16896ull * 512 * 2;
constexpr size_t OFF_KB   = OFF_QB + 16896ull * 256 * 2;
constexpr size_t OFF_VBT  = OFF_KB + 16896ull * 256 * 2;
constexpr size_t OFF_VBTS = OFF_VBT + 2ull * 512 * 8192 * 2;
constexpr size_t OFF_LOGA = OFF_VBTS + 32ull * 512 * 16 * 2;
constexpr size_t OFF_ZB   = OFF_LOGA + 16896ull * 256 * 4;
constexpr size_t OFF_QM   = OFF_ZB + 16896ull * 512 * 2;
constexpr size_t OFF_ZM   = OFF_QM + 16896ull * 256 * 2;
constexpr size_t OFF_MK   = OFF_ZM + 16896ull * 256 * 2;
constexpr size_t OFF_MVT  = OFF_MK + 512ull * 256 * 2;
constexpr size_t OFF_MKS  = OFF_MVT + 2ull * 256 * 256 * 2;
constexpr size_t OFF_MVST = OFF_MKS + 32ull * 256 * 256 * 2;
constexpr size_t OFF_DEC  = OFF_MVST + 32ull * 256 * 256 * 2;
constexpr size_t OFF_SGS  = OFF_DEC + 1024ull * 64 * 4;
constexpr size_t OFF_BAR  = OFF_SGS + 512ull * 3072 * 2;
constexpr size_t WS_END   = OFF_BAR + 16384;
constexpr size_t OFF_SG   = OFF_QA;
constexpr size_t OFF_UB   = OFF_SG + 16896ull * 1024 * 2;
static_assert(OFF_UB + 16896ull * 1024 * 2 <= OFF_ZA, "overlay");
static_assert(WS_END <= 268435456ull, "workspace");

constexpr size_t O_SPB = 8388608;
constexpr size_t O_Y = 0, O_AKP = 17301504, O_AVP = 17825792, O_GLP = 18350080, O_MKP = 18415616, O_MVP = 18546688,
                 O_AKS = 18677760, O_AVS = 18939904, O_GLS = 19202048;

constexpr int LDS_WAVE = 18432;
constexpr int LDS_TAB = 8448;
constexpr int LDS_BAR = LDS_TAB + 8 * LDS_WAVE;
constexpr int LDS_BYTES = LDS_BAR + 16;

struct Params {
    const float *x_prompt, *x_sample, *mem_prompt, *cache_a_k, *cache_a_v, *state_gla, *cache_mem_k, *cache_mem_v,
        *norm_in, *w_in, *g_qa, *g_ka, *rel_bias, *w_gate2, *b_gate, *g_gla_out, *g_mem, *w_mem_kv, *g_qm, *g_km,
        *w_up_a, *w_up_b, *w_up_m, *w_out;
    float* out;
    unsigned char* ws;
};

constexpr int HTB = 128 * 64 * 2;
#ifndef GEMM_SP2
#define GEMM_SP2 1
#endif
#ifndef GEMM_ALIGN
#define GEMM_ALIGN 1
#endif
DI int lds_byte(int r, int c) { const int st = (r >> 4) * 2 + (c >> 5), rr = r & 15, cc = c & 31, ob = rr * 64 + cc * 2; return st * 1024 + (ob ^ (((ob >> 9) & 1) << 5)); }
DI void stage_rc(int b, int& R, int& C) { const int st = b / 1024, sb = b % 1024, swz = sb ^ (((sb >> 9) & 1) << 5); R = (st >> 1) * 16 + swz / 64; C = (st & 1) * 32 + (swz % 64) / 2; }
DI int perm32(int rho) { const int n = rho >> 4, i = rho & 15; return 8 * (i >> 2) + 4 * n + (i & 3); }

enum { K_QNORM = 0, K_KNORM, K_MEMK, K_VA, K_VB, K_MEMV, K_SILU, K_SCALE, K_LOGA, K_GATE, K_UP0, K_UP1, K_OUT };
struct Unit { const char* A; const char* B; int nt; int ldb; int kind; int pm; int coff; int aux; };

DI void static_order(int L, int nM, int nN, int nwg, int& pm, int& pn) {
    int wgid = L; { const int q = nwg / 8, r = nwg % 8, xcd = wgid % 8, off = wgid / 8; wgid = (xcd < r ? xcd * (q + 1) : r * (q + 1) + (xcd - r) * q) + off; }
    const int nig = 8 * nN, gid = wgid / nig, fm = gid * 8, gsz = (nM - fm) < 8 ? (nM - fm) : 8;
    pm = fm + ((wgid % nig) % gsz); pn = (wgid % nig) / gsz;
}

template <int PH> DI bool get_unit(const Params& p, int i, Unit& u, int mode) {
    const int G = gridDim.x, c = blockIdx.x;
    const char* ws = (const char*)p.ws;
    if constexpr (PH == 1) {
        const int L = i * G + c; constexpr int nwg = 66 * 17;
        if (L >= nwg + 4 + 24) return false;
        u.nt = 16; u.ldb = 2048; u.aux = 0; u.coff = 0;
        if (L >= nwg + 4) {
            const int e = L - nwg - 4, pm = 64 + e / 12, gt = e % 12;
            u.pm = pm; u.kind = K_GATE; u.coff = gt * 256;
            u.A = ws + OFF_H + (size_t)pm * 256 * 2048; u.B = ws + OFF_WINT + (size_t)(17 + gt) * 256 * 2048;
            return true;
        }
        if (L >= nwg) {
            const int e = L - nwg, pmm = e >> 1;
            u.pm = pmm;
            if ((e & 1) == 0) { u.kind = K_MEMK; u.A = ws + OFF_MEMH + (size_t)pmm * 256 * 2048; u.B = ws + OFF_WMEM; }
            else { u.kind = K_MEMV; u.A = ws + OFF_WMEM + (size_t)256 * 2048; u.B = ws + OFF_MEMH + (size_t)pmm * 256 * 2048; }
            return true;
        }
        int pm, t; static_order(L, 66, 17, nwg, pm, t);
        u.pm = pm;
        const char* hp = ws + OFF_H + (size_t)pm * 256 * 2048; const char* wp = ws + OFF_WINT + (size_t)t * 256 * 2048;
        const bool sw = (t == 4 || t == 5 || t == 10 || t == 11);
        u.A = sw ? wp : hp; u.B = sw ? hp : wp;
        if (t < 2) { u.kind = K_QNORM; u.coff = t * 256; }
        else if (t < 4) { u.kind = K_KNORM; u.coff = (t - 2) * 256; }
        else if (t < 6) { u.kind = K_VA; u.coff = (t - 4) * 256; }
        else if (t < 8) { u.kind = K_SILU; u.coff = (t - 6) * 256; }
        else if (t == 8) { u.kind = K_SCALE; }
        else if (t == 9) { u.kind = K_SCALE; u.aux = 1; }
        else if (t < 12) { u.kind = K_VB; u.coff = (t - 10) * 256; }
        else if (t == 12) { u.kind = K_LOGA; }
        else if (t < 15) { u.kind = K_SILU; u.aux = 1; u.coff = (t - 13) * 256; }
        else if (t == 15) { u.kind = K_QNORM; u.aux = 1; }
        else { u.kind = K_SILU; u.aux = 2; }
        return true;
    } else if constexpr (PH == 5) {
        int pm, pn, br, isup;
        if (mode == 0) {
            const int gi = i / 6, s = i - gi * 6, L = gi * G + c;
            if (L >= 256) return false;
            static_order(L, 64, 4, 256, pm, pn);
            br = s >> 1; isup = s & 1; u.aux = 0;
        } else {
            if (i >= 3 || c >= 8) return false;
            pm = 64 + (c >> 2); pn = c & 3; br = i; isup = 1; u.aux = 1 + br;
        }
        u.pm = pm; u.coff = pn * 256;
        if (!isup) {
            u.kind = K_GATE; u.nt = 16; u.ldb = 2048;
            u.A = ws + OFF_H + (size_t)pm * 256 * 2048; u.B = ws + OFF_WINT + (size_t)(17 + 4 * br + pn) * 256 * 2048;
        } else {
            u.kind = br == 0 ? K_UP0 : K_UP1;
            if (br == 0) { u.nt = 8; u.ldb = 1024; u.A = ws + OFF_ZA + (size_t)pm * 256 * 1024; u.B = ws + OFF_WUPA + (size_t)pn * 256 * 1024; }
            else if (br == 1) { u.nt = 8; u.ldb = 1024; u.A = ws + OFF_ZB + (size_t)pm * 256 * 1024; u.B = ws + OFF_WUPB + (size_t)pn * 256 * 1024; }
            else { u.nt = 4; u.ldb = 512; u.A = ws + OFF_ZM + (size_t)pm * 256 * 512; u.B = ws + OFF_WUPM + (size_t)pn * 256 * 512; }
        }
        return true;
    } else {
        int pm, pn;
        if (mode == 0) { const int L = i * G + c; if (L >= 256) return false; static_order(L, 64, 4, 256, pm, pn); }
        else { if (i >= 1 || c >= 8) return false; pm = 64 + (c >> 2); pn = c & 3; }
        u.pm = pm; u.coff = pn * 256; u.aux = 0; u.kind = K_OUT; u.nt = 16; u.ldb = 2048;
        u.A = ws + OFF_UB + (size_t)pm * 256 * 2048; u.B = ws + OFF_WOUT + (size_t)pn * 256 * 2048;
        return true;
    }
}

DI float sigmoidf_(float v) { return __fdividef(1.f, 1.f + __expf(-v)); }

template <int PH>
DI void epilogue(const Params& p, const f32x4 (&acc)[2][2][4][2], const Unit& u, int wr, int wc, int fr, int fq) {
    unsigned char* ws = p.ws;
    const int kind = u.kind;
    const int rl0 = 64 * wr + fr;
    const int cl0 = 64 * wc + 8 * fq;
    if constexpr (PH == 1) {
        if (kind <= K_MEMK) {
            const float* g = kind == K_QNORM ? (u.aux ? p.g_qm : p.g_qa) : (kind == K_KNORM ? p.g_ka : p.g_km);
            const float sc = kind == K_QNORM ? QSCALE : 1.f;
            f32x4 gv[2][2];
#pragma unroll
            for (int bj = 0; bj < 2; ++bj)
#pragma unroll
                for (int n = 0; n < 2; ++n) gv[bj][n] = *(const f32x4*)(g + 32 * bj + 8 * fq + 4 * n) * sc;
#pragma unroll
            for (int ai = 0; ai < 2; ++ai)
#pragma unroll
                for (int m = 0; m < 4; ++m) {
                    const int r = u.pm * 256 + rl0 + 128 * ai + 16 * m;
                    float ss = 0.f;
#pragma unroll
                    for (int bj = 0; bj < 2; ++bj)
#pragma unroll
                        for (int n = 0; n < 2; ++n) { const f32x4 v = acc[ai][bj][m][n]; ss += v[0] * v[0] + v[1] * v[1] + v[2] * v[2] + v[3] * v[3]; }
                    ss += __shfl_xor(ss, 16); ss += __shfl_xor(ss, 32);
                    const float rstd = rsqrtf(ss * (1.f / 64.f) + EPS);
                    bf16_t* d16; float* d32 = nullptr;
                    if (kind == K_QNORM) {
                        d16 = u.aux ? (bf16_t*)(ws + OFF_QM) + (size_t)r * 256 + cl0 : (bf16_t*)(ws + OFF_QA) + (size_t)r * 512 + u.coff + cl0;
                    } else if (kind == K_KNORM) {
                        if (u.pm < 64) {
                            d16 = (bf16_t*)(ws + OFF_KA) + (size_t)r * 512 + u.coff + cl0;
                            if ((u.pm & 31) >= 30) d32 = p.out + O_AKP + (size_t)((r >> 13) * 512 + (r & 8191) - 7680) * 512 + u.coff + cl0;
                        } else {
                            const int rs = r - T_P;
                            d16 = (bf16_t*)(ws + OFF_KS) + (size_t)(rs + 512 * ((rs >> 4) + 1)) * 512 + u.coff + cl0;
                            d32 = p.out + O_AKS + (size_t)rs * 512 + u.coff + cl0;
                        }
                    } else {
                        d16 = (bf16_t*)(ws + OFF_MK) + (size_t)r * 256 + cl0;
                        d32 = p.out + O_MKP + (size_t)r * 256 + cl0;
                    }
#pragma unroll
                    for (int bj = 0; bj < 2; ++bj) {
                        const f32x4 v0 = acc[ai][bj][m][0] * rstd * gv[bj][0], v1 = acc[ai][bj][m][1] * rstd * gv[bj][1];
                        *(u32x4*)(d16 + 32 * bj) = pack8(v0, v1);
                        if (d32) { *(f32x4*)(d32 + 32 * bj) = v0; *(f32x4*)(d32 + 32 * bj + 4) = v1; }
                    }
                }
        } else if (kind <= K_MEMV) {
#pragma unroll
            for (int ai = 0; ai < 2; ++ai)
#pragma unroll
                for (int m = 0; m < 4; ++m) {
                    const int f = u.coff + rl0 + 128 * ai + 16 * m;
#pragma unroll
                    for (int bj = 0; bj < 2; ++bj) {
                        const int tc = 128 * bj + 32 * wc + 8 * fq;
                        const f32x4 v0 = acc[ai][bj][m][0], v1 = acc[ai][bj][m][1];
                        const u32x4 w = pack8(v0, v1);
                        if (kind == K_MEMV) {
                            const int b = u.pm;
                            *(u32x4*)((bf16_t*)(ws + OFF_MVT) + (size_t)(b * 256 + f) * 256 + tc) = w;
                            float* o = p.out + O_MVP + (size_t)(b * 256 + tc) * 256 + f;
#pragma unroll
                            for (int j = 0; j < 4; ++j) { o[(size_t)j * 256] = v0[j]; o[(size_t)(4 + j) * 256] = v1[j]; }
                        } else if (u.pm < 64) {
                            const int b = u.pm >> 5, t = (u.pm & 31) * 256 + tc;
                            if (kind == K_VA) *(u32x4*)((bf16_t*)(ws + OFF_VAT) + (size_t)(b * 512 + f) * VLD + t) = w;
                            else *(u32x4*)((bf16_t*)(ws + OFF_VBT) + ((size_t)(((b * 4 + (f >> 7)) * 128 + (t >> 6)) * 4 + ((f & 127) >> 5)) * 8 + ((t & 63) >> 3)) * 256 + (f & 31) * 8) = w;
                            if (kind == K_VA && (u.pm & 31) >= 30) {
                                float* o = p.out + O_AVP + (size_t)(b * 512 + t - 7680) * 512 + f;
#pragma unroll
                                for (int j = 0; j < 4; ++j) { o[(size_t)j * 512] = v0[j]; o[(size_t)(4 + j) * 512] = v1[j]; }
                            }
                        } else {
                            const int rs = (u.pm - 64) * 256 + tc, sb = rs >> 4, i = rs & 15;
                            if (kind == K_VA) {
                                *(u32x4*)((bf16_t*)(ws + OFF_VST) + (size_t)(sb * 512 + f) * 528 + 512 + i) = w;
                                float* o = p.out + O_AVS + (size_t)rs * 512 + f;
#pragma unroll
                                for (int j = 0; j < 4; ++j) { o[(size_t)j * 512] = v0[j]; o[(size_t)(4 + j) * 512] = v1[j]; }
                            } else {
                                *(u32x4*)((bf16_t*)(ws + OFF_VBTS) + (size_t)(sb * 512 + f) * 16 + i) = w;
                            }
                        }
                    }
                }
        } else if (kind == K_LOGA) {
            f32x4 bv[2][2];
#pragma unroll
            for (int bj = 0; bj < 2; ++bj)
#pragma unroll
                for (int n = 0; n < 2; ++n) bv[bj][n] = *(const f32x4*)(p.b_gate + cl0 + 32 * bj + 4 * n);
#pragma unroll
            for (int ai = 0; ai < 2; ++ai)
#pragma unroll
                for (int m = 0; m < 4; ++m) {
                    const int r = u.pm * 256 + rl0 + 128 * ai + 16 * m;
                    float* d = (float*)(ws + OFF_LOGA) + (size_t)r * 256 + cl0;
#pragma unroll
                    for (int bj = 0; bj < 2; ++bj)
#pragma unroll
                        for (int n = 0; n < 2; ++n) {
                            const f32x4 x = acc[ai][bj][m][n] + bv[bj][n]; f32x4 o;
#pragma unroll
                            for (int j = 0; j < 4; ++j) o[j] = -(fmaxf(-x[j], 0.f) + __logf(1.f + __expf(-fabsf(x[j])))) * (1.f / 16.f);
                            *(f32x4*)(d + 32 * bj + 4 * n) = o;
                        }
                }
        } else {
            bf16_t* base; int ld; float sc = 1.f;
            if (kind == K_GATE) { base = (bf16_t*)(ws + OFF_SGS) - (size_t)T_P * 3072; ld = 3072; }
            else if (kind == K_SILU) { base = (bf16_t*)(ws + (u.aux == 0 ? OFF_ZA : (u.aux == 1 ? OFF_ZB : OFF_ZM))); ld = u.aux == 2 ? 256 : 512; }
            else { base = (bf16_t*)(ws + (u.aux == 0 ? OFF_QB : OFF_KB)); ld = 256; sc = u.aux == 0 ? 0.125f : 1.f; }
#pragma unroll
            for (int ai = 0; ai < 2; ++ai)
#pragma unroll
                for (int m = 0; m < 4; ++m) {
                    const int r = u.pm * 256 + rl0 + 128 * ai + 16 * m;
                    bf16_t* d = base + (size_t)r * ld + u.coff + cl0;
#pragma unroll
                    for (int bj = 0; bj < 2; ++bj) {
                        f32x4 v0 = acc[ai][bj][m][0], v1 = acc[ai][bj][m][1];
                        if (kind == K_SILU) {
#pragma unroll
                            for (int j = 0; j < 4; ++j) { v0[j] = v0[j] * sigmoidf_(v0[j]); v1[j] = v1[j] * sigmoidf_(v1[j]); }
                        } else if (kind == K_GATE) {
#pragma unroll
                            for (int j = 0; j < 4; ++j) { v0[j] = sigmoidf_(v0[j]); v1[j] = sigmoidf_(v1[j]); }
                        } else { v0 = v0 * sc; v1 = v1 * sc; }
                        *(u32x4*)(d + 32 * bj) = pack8(v0, v1);
                    }
                }
        }
    } else if constexpr (PH == 5) {
        const bf16_t* gsrc = u.aux == 0 ? (const bf16_t*)(ws + OFF_SG) + u.coff + cl0 : (const bf16_t*)(ws + OFF_SGS) - (size_t)T_P * 3072 + (u.aux - 1) * 1024 + u.coff + cl0;
        const int gld = u.aux == 0 ? 1024 : 3072;
#pragma unroll
        for (int ai = 0; ai < 2; ++ai) {
            if (kind == K_GATE) {
#pragma unroll
                for (int m = 0; m < 4; ++m) {
                    const int r = u.pm * 256 + rl0 + 128 * ai + 16 * m;
                    bf16_t* sg = (bf16_t*)(ws + OFF_SG) + (size_t)r * 1024 + u.coff + cl0;
#pragma unroll
                    for (int bj = 0; bj < 2; ++bj) {
                        f32x4 v0 = acc[ai][bj][m][0], v1 = acc[ai][bj][m][1];
#pragma unroll
                        for (int j = 0; j < 4; ++j) { v0[j] = sigmoidf_(v0[j]); v1[j] = sigmoidf_(v1[j]); }
                        *(u32x4*)(sg + 32 * bj) = pack8(v0, v1);
                    }
                }
            } else {
                u32x4 sv[4][2], qv[4][2];
#pragma unroll
                for (int m = 0; m < 4; ++m) {
                    const int r = u.pm * 256 + rl0 + 128 * ai + 16 * m;
#pragma unroll
                    for (int bj = 0; bj < 2; ++bj) {
                        sv[m][bj] = *(const u32x4*)(gsrc + (size_t)r * gld + 32 * bj);
                        if (kind == K_UP1) qv[m][bj] = *(const u32x4*)((const bf16_t*)(ws + OFF_UB) + (size_t)r * 1024 + u.coff + cl0 + 32 * bj);
                    }
                }
#pragma unroll
                for (int m = 0; m < 4; ++m) {
                    const int r = u.pm * 256 + rl0 + 128 * ai + 16 * m;
                    bf16_t* ub = (bf16_t*)(ws + OFF_UB) + (size_t)r * 1024 + u.coff + cl0;
#pragma unroll
                    for (int bj = 0; bj < 2; ++bj) {
                        f32x4 v0 = acc[ai][bj][m][0], v1 = acc[ai][bj][m][1];
                        const u32x4 sq = sv[m][bj];
                        v0[0] *= bflo(sq.x); v0[1] *= bfhi(sq.x); v0[2] *= bflo(sq.y); v0[3] *= bfhi(sq.y);
                        v1[0] *= bflo(sq.z); v1[1] *= bfhi(sq.z); v1[2] *= bflo(sq.w); v1[3] *= bfhi(sq.w);
                        if (kind == K_UP1) {
                            const u32x4 q = qv[m][bj];
                            v0[0] += bflo(q.x); v0[1] += bfhi(q.x); v0[2] += bflo(q.y); v0[3] += bfhi(q.y);
                            v1[0] += bflo(q.z); v1[1] += bfhi(q.z); v1[2] += bflo(q.w); v1[3] += bfhi(q.w);
                        }
                        *(u32x4*)(ub + 32 * bj) = pack8(v0, v1);
                    }
                }
            }
        }
    } else {
#pragma unroll
        for (int ai = 0; ai < 2; ++ai) {
            f32x4 xv[4][2][2];
#pragma unroll
            for (int m = 0; m < 4; ++m) {
                const int r = u.pm * 256 + rl0 + 128 * ai + 16 * m;
                const float* xr = (r < T_P ? p.x_prompt + (size_t)r * 1024 : p.x_sample + (size_t)(r - T_P) * 1024) + u.coff + cl0;
#pragma unroll
                for (int bj = 0; bj < 2; ++bj)
#pragma unroll
                    for (int n = 0; n < 2; ++n) xv[m][bj][n] = *(const f32x4*)(xr + 32 * bj + 4 * n);
            }
#pragma unroll
            for (int m = 0; m < 4; ++m) {
                const int r = u.pm * 256 + rl0 + 128 * ai + 16 * m;
                float* yr = p.out + O_Y + (size_t)r * 1024 + u.coff + cl0;
#pragma unroll
                for (int bj = 0; bj < 2; ++bj)
#pragma unroll
                    for (int n = 0; n < 2; ++n) *(f32x4*)(yr + 32 * bj + 4 * n) = acc[ai][bj][m][n] + xv[m][bj][n];
            }
        }
    }
}

template <int PH>
DI void gemm_phase(const Params& p, LAS unsigned char* lds, int mode) {
    int tid = threadIdx.x; asm volatile("" : "+v"(tid));
    const int wid = __builtin_amdgcn_readfirstlane(tid >> 6), lane = tid & 63, wr = wid >> 2, wc = wid & 3, fr = lane & 15, fq = lane >> 4;
    int rA[2], rB[2], c2[2];
#pragma unroll
    for (int i = 0; i < 2; ++i) { int R, C; stage_rc(tid * 16 + i * 8192, R, C); rA[i] = R; rB[i] = (R & ~31) + perm32(R & 31); c2[i] = C * 2; }
    const unsigned ldsw = (unsigned)wid * 1024u;
    const int aoff = lds_byte(wr * 64 + fr, fq * 8), boff = lds_byte(wc * 32 + fr, fq * 8);
#define G_SA(b, h) (((b) * 2 + (h)) * HTB)
#define G_SB(b, h) ((4 + (b) * 2 + (h)) * HTB)
#define G_STAGE(bufoff, gbase, rows, ldbv) do { _Pragma("unroll") for (int _i = 0; _i < 2; ++_i) \
        __builtin_amdgcn_global_load_lds((const unsigned*)((const char*)(gbase) + (unsigned)((rows)[_i] * (ldbv) + c2[_i])), (LAS unsigned*)(lds + (bufoff) + ldsw + _i * 8192), 16, 0, 0); } while (0)
#define G_LDA(dst, b, h) do { _Pragma("unroll") for (int m = 0; m < 4; ++m) _Pragma("unroll") for (int k = 0; k < 2; ++k) dst[m][k] = *(const LAS bf16x8*)(lds + G_SA(b, h) + aoff + m * 2048 + k * 1024); } while (0)
#define G_LDB(dst, b, h) do { _Pragma("unroll") for (int n = 0; n < 2; ++n) _Pragma("unroll") for (int k = 0; k < 2; ++k) dst[n][k] = *(const LAS bf16x8*)(lds + G_SB(b, h) + boff + n * 2048 + k * 1024); } while (0)
#define G_MMA(ai, bj, At, Bt) do { __builtin_amdgcn_s_setprio(1); _Pragma("unroll") for (int m = 0; m < 4; ++m) _Pragma("unroll") for (int n = 0; n < 2; ++n) _Pragma("unroll") for (int k = 0; k < 2; ++k) \
        acc[ai][bj][m][n] = __builtin_amdgcn_mfma_f32_16x16x32_bf16(Bt[n][k], At[m][k], acc[ai][bj][m][n], 0, 0, 0); __builtin_amdgcn_s_setprio(0); } while (0)
#define G_WAIT_V(n) asm volatile("s_waitcnt vmcnt(" #n ")" ::: "memory")
#define G_WAIT_L(n) asm volatile("s_waitcnt lgkmcnt(" #n ")" ::: "memory")
#define G_BAR __builtin_amdgcn_s_barrier()
#define G_SCHED __builtin_amdgcn_sched_barrier(0)
    Unit cur, nxt; int ui = 0;
    if (!get_unit<PH>(p, 0, cur, mode)) return;
    f32x4 acc[2][2][4][2];
#pragma unroll
    for (int a = 0; a < 2; ++a)
#pragma unroll
        for (int b = 0; b < 2; ++b)
#pragma unroll
            for (int m = 0; m < 4; ++m)
#pragma unroll
                for (int n = 0; n < 2; ++n) acc[a][b][m][n] = (f32x4){0.f, 0.f, 0.f, 0.f};
    bf16x8 At[4][2], B0[2][2], B1[2][2];
    const char* cA = cur.A; const char* cB = cur.B; int cl = cur.ldb; size_t ch = (size_t)128 * cl;
    if (GEMM_SP2) {
        G_STAGE(G_SB(0, 0), cB, rB, cl); G_STAGE(G_SB(0, 1), cB + ch, rB, cl); G_STAGE(G_SA(0, 0), cA, rA, cl); G_STAGE(G_SA(0, 1), cA + ch, rA, cl);
        if (wr == 1) G_BAR;
        G_WAIT_V(2); G_BAR;
        G_STAGE(G_SB(1, 0), cB + 128, rB, cl); G_STAGE(G_SA(1, 0), cA + 128, rA, cl); G_STAGE(G_SB(1, 1), cB + ch + 128, rB, cl);
        G_WAIT_V(6); G_BAR;
    } else {
        G_STAGE(G_SB(0, 0), cB, rB, cl); G_STAGE(G_SA(0, 0), cA, rA, cl); G_STAGE(G_SB(0, 1), cB + ch, rB, cl); G_STAGE(G_SA(0, 1), cA + ch, rA, cl);
        if (wr == 1) G_BAR;
        G_WAIT_V(4); G_BAR;
        G_STAGE(G_SB(1, 0), cB + 128, rB, cl); G_STAGE(G_SA(1, 0), cA + 128, rA, cl); G_STAGE(G_SB(1, 1), cB + ch + 128, rB, cl);
        G_WAIT_V(6); G_BAR;
    }
    for (;;) {
        const bool has_next = get_unit<PH>(p, ui + 1, nxt, mode);
        const char* nA = has_next ? nxt.A : cA; const char* nB = has_next ? nxt.B : cB; const int nl = has_next ? nxt.ldb : cl; const size_t nh = (size_t)128 * nl;
        const int nt = cur.nt;
        for (int t = 0; t < nt; t += 2) {
            const bool last = (t == nt - 2);
            const char* a1 = cA + (size_t)(t + 1) * 128;
            const char* a2 = last ? nA : cA + (size_t)(t + 2) * 128; const char* b2 = last ? nB : cB + (size_t)(t + 2) * 128;
            const int l2 = last ? nl : cl; const size_t h2 = last ? nh : ch;
            const char* a3 = a2 + 128; const char* b3 = b2 + 128;
            if (GEMM_SP2) {
                G_LDB(B0, 0, 0); G_LDB(B1, 0, 1); G_SCHED; G_LDA(At, 0, 0); G_STAGE(G_SA(1, 1), a1 + ch, rA, cl);
                G_WAIT_V(8); G_WAIT_L(0); G_BAR; G_MMA(0, 0, At, B0); G_MMA(0, 1, At, B1); G_BAR; G_SCHED;
                G_LDA(At, 0, 1); G_STAGE(G_SB(0, 0), b2, rB, l2); G_STAGE(G_SB(0, 1), b2 + h2, rB, l2); G_STAGE(G_SA(0, 0), a2, rA, l2);
                G_WAIT_V(8); G_WAIT_L(0); G_BAR; G_MMA(1, 0, At, B0); G_MMA(1, 1, At, B1); G_BAR; G_SCHED;
                G_LDB(B0, 1, 0); G_LDB(B1, 1, 1); G_SCHED; G_LDA(At, 1, 0); G_STAGE(G_SA(0, 1), a2 + h2, rA, l2);
                G_WAIT_V(8); G_WAIT_L(0); G_BAR; G_MMA(0, 0, At, B0); G_MMA(0, 1, At, B1); G_BAR; G_SCHED;
                G_LDA(At, 1, 1); G_STAGE(G_SB(1, 0), b3, rB, l2); G_STAGE(G_SB(1, 1), b3 + h2, rB, l2); G_STAGE(G_SA(1, 0), a3, rA, l2);
                G_WAIT_V(8); G_WAIT_L(0); G_BAR; G_MMA(1, 0, At, B0); G_MMA(1, 1, At, B1); G_BAR; G_SCHED;
            } else {
                G_LDB(B0, 0, 0); G_SCHED; G_LDA(At, 0, 0); G_STAGE(G_SA(1, 1), a1 + ch, rA, cl);
                G_WAIT_L(8); G_BAR; G_WAIT_L(0); G_MMA(0, 0, At, B0); G_BAR; G_SCHED;
                G_LDB(B1, 0, 1); G_STAGE(G_SB(0, 0), b2, rB, l2);
                G_BAR; G_WAIT_L(0); G_MMA(0, 1, At, B1); G_BAR;
                G_LDA(At, 0, 1); G_STAGE(G_SA(0, 0), a2, rA, l2);
                G_BAR; G_WAIT_L(0); G_MMA(1, 0, At, B0); G_BAR; G_SCHED;
                G_STAGE(G_SB(0, 1), b2 + h2, rB, l2);
                G_WAIT_V(6); G_BAR; G_MMA(1, 1, At, B1); G_BAR;
                G_LDB(B0, 1, 0); G_SCHED; G_LDA(At, 1, 0); G_STAGE(G_SA(0, 1), a2 + h2, rA, l2);
                G_WAIT_L(8); G_BAR; G_WAIT_L(0); G_MMA(0, 0, At, B0); G_BAR; G_SCHED;
                G_LDB(B1, 1, 1); G_STAGE(G_SB(1, 0), b3, rB, l2);
                G_BAR; G_WAIT_L(0); G_MMA(0, 1, At, B1); G_BAR;
                G_LDA(At, 1, 1); G_STAGE(G_SA(1, 0), a3, rA, l2);
                G_BAR; G_WAIT_L(0); G_MMA(1, 0, At, B0); G_BAR; G_SCHED;
                G_STAGE(G_SB(1, 1), b3 + h2, rB, l2);
                G_WAIT_V(6); G_BAR; G_MMA(1, 1, At, B1); G_BAR;
            }
        }
        if (GEMM_ALIGN) { if (wr == 0) G_BAR; }
        epilogue<PH>(p, acc, cur, wr, wc, fr, fq);
        if (!has_next) break;
#pragma unroll
        for (int a = 0; a < 2; ++a)
#pragma unroll
            for (int b = 0; b < 2; ++b)
#pragma unroll
                for (int m = 0; m < 4; ++m)
#pragma unroll
                    for (int n = 0; n < 2; ++n) acc[a][b][m][n] = (f32x4){0.f, 0.f, 0.f, 0.f};
        cur = nxt; cA = nA; cB = nB; cl = nl; ch = nh; ++ui;
        if (GEMM_ALIGN) { if (wr == 1) G_BAR; }
    }
    G_WAIT_V(0);
    if (!GEMM_ALIGN) { if (wr == 0) G_BAR; }
    G_BAR;
}

DI void transpose_item(const float* W, int ldw, bf16_t* WT, int ldt, LAS float* scr, int lane) {
    float tv[32];
#pragma unroll
    for (int i = 0; i < 32; ++i) tv[i] = W[(size_t)(2 * i + (lane >> 5)) * ldw + (lane & 31)];
#pragma unroll
    for (int i = 0; i < 32; ++i) scr[(2 * i + (lane >> 5)) * 33 + (lane & 31)] = tv[i];
    LDS_WAIT();
    const int c = lane & 7;
#pragma unroll
    for (int j = 0; j < 4; ++j) {
        const int n = (lane >> 3) + 8 * j; const LAS float* s = scr + (8 * c) * 33 + n;
        u32x4 o; o.x = pk2(s[0 * 33], s[1 * 33]); o.y = pk2(s[2 * 33], s[3 * 33]); o.z = pk2(s[4 * 33], s[5 * 33]); o.w = pk2(s[6 * 33], s[7 * 33]);
        *(u32x4*)(WT + (size_t)n * ldt + 8 * c) = o;
    }
    LDS_WAIT();
}

DI void transpose_item64(const float* W, int ldw, bf16_t* WT0, bf16_t* WT1, int ldt, LAS float* scr, int lane) {
    float tv[64];
#pragma unroll
    for (int i = 0; i < 64; ++i) tv[i] = W[(size_t)i * ldw + lane];
    __builtin_amdgcn_sched_barrier(0);
#pragma unroll
    for (int i = 0; i < 64; ++i) scr[i * 65 + lane] = tv[i];
    LDS_WAIT();
    const int c = lane & 7;
#pragma unroll
    for (int j = 0; j < 8; ++j) {
        const int n = (lane >> 3) + 8 * j; const LAS float* sp = scr + (8 * c) * 65 + n;
        u32x4 o; o.x = pk2(sp[0 * 65], sp[1 * 65]); o.y = pk2(sp[2 * 65], sp[3 * 65]); o.z = pk2(sp[4 * 65], sp[5 * 65]); o.w = pk2(sp[6 * 65], sp[7 * 65]);
        bf16_t* dst = (j < 4 ? WT0 + (size_t)n * ldt : WT1 + (size_t)(n - 32) * ldt) + 8 * c;
        *(u32x4*)dst = o;
    }
    LDS_WAIT();
}

DI float wave_sum(float v) {
#pragma unroll
    for (int o = 1; o < 64; o <<= 1) v += __shfl_xor(v, o);
    return v;
}

DI void rows_job(const float* src, const float* g, bf16_t* dst, int nrows, int woff, int gw, int NGW, int lane) {
    int s0 = gw - woff; if (s0 < 0) s0 += NGW;
    for (int r0 = s0; r0 < nrows; r0 += 4 * NGW) {
        f32x4 v[4][4];
#pragma unroll
        for (int q = 0; q < 4; ++q) {
            const int r = r0 + q * NGW;
            if (r < nrows) {
#pragma unroll
                for (int j = 0; j < 4; ++j) v[q][j] = ((const f32x4*)(src + (size_t)r * 1024))[lane + 64 * j]; }
        }
#pragma unroll
        for (int q = 0; q < 4; ++q) {
            const int r = r0 + q * NGW;
            if (r < nrows) {
                float ssum = 0.f;
#pragma unroll
                for (int j = 0; j < 4; ++j) ssum += (v[q][j][0] * v[q][j][0] + v[q][j][1] * v[q][j][1]) + (v[q][j][2] * v[q][j][2] + v[q][j][3] * v[q][j][3]);
                const float rstd = rsqrtf(wave_sum(ssum) * (1.f / 1024.f) + EPS);
#pragma unroll
                for (int j = 0; j < 4; ++j) { const f32x4 gg = ((const f32x4*)g)[lane + 64 * j]; u32x2 w; w.x = pk2(v[q][j][0] * rstd * gg[0], v[q][j][1] * rstd * gg[1]); w.y = pk2(v[q][j][2] * rstd * gg[2], v[q][j][3] * rstd * gg[3]); ((u32x2*)(dst + (size_t)r * 1024))[lane + 64 * j] = w; }
            }
        }
    }
}

DI int lgrp(int g) { return 2 * (g & 3) + (g >> 2); }

DI void p0_prep(const Params& p, LAS unsigned char* lds) {
    int tid = threadIdx.x; asm volatile("" : "+v"(tid));
    const int lane = tid & 63, wid = __builtin_amdgcn_readfirstlane(tid >> 6);
    const int gw = blockIdx.x * 8 + wid, NGW = gridDim.x * 8;
    unsigned char* ws = p.ws;
    LAS float* scr = (LAS float*)(lds + wid * 18432);
    constexpr int J1 = 28 * 64, J2 = J1 + 128, J3 = J2 + 256, J4 = J3 + 256, J5 = J4 + 128, J6 = J5 + 512;
    LAS float* scr64 = (LAS float*)(lds + wid * 18432);
    for (int it = gw; it < J6; it += NGW) {
        if (it < J1) {
            int t = it >> 6; const int rem = it & 63, wcq = rem >> 4, kb = rem & 15; if (t >= 12) t += 1;
            const bool sw = (t == 4 || t == 5 || t == 10 || t == 11);
            const int src = (t < 12 ? 256 * t : 256 * (t - 1) + 16) + 64 * wcq;
            bf16_t* base = (bf16_t*)(ws + OFF_WINT) + (size_t)(t * 256) * 1024 + 64 * kb;
            transpose_item64(p.w_in + (size_t)(64 * kb) * 7184 + src, 7184, base + (size_t)(sw ? 64 * wcq : 32 * wcq) * 1024, base + (size_t)(sw ? 64 * wcq + 32 : 128 + 32 * wcq) * 1024, 1024, scr64, lane);
        } else if (it < J2) {
            const int j = it - J1, t = j >> 6, rem = j & 63, wcq = rem >> 4, kb = rem & 15;
            bf16_t* base = (bf16_t*)(ws + OFF_WMEM) + (size_t)(t * 256) * 1024 + 64 * kb;
            transpose_item64(p.w_mem_kv + (size_t)(64 * kb) * 512 + 256 * t + 64 * wcq, 512, base + (size_t)(t ? 64 * wcq : 32 * wcq) * 1024, base + (size_t)(t ? 64 * wcq + 32 : 128 + 32 * wcq) * 1024, 1024, scr64, lane);
        } else if (it < J4) {
            const int j0 = it - J2, which = j0 >> 8, j = j0 & 255, t = j >> 6, rem = j & 63, g = rem >> 3, kb = rem & 7;
            const float* W = which ? p.w_up_b : p.w_up_a;
            transpose_item(W + (size_t)(64 * kb) * 1024 + 256 * t + 32 * lgrp(g), 1024, (bf16_t*)(ws + (which ? OFF_WUPB : OFF_WUPA)) + (size_t)(t * 256 + 32 * g) * 512 + 64 * kb, 512, scr, lane);
        } else if (it < J5) {
            const int j = it - J4, t = j >> 5, rem = j & 31, g = rem >> 2, kb = rem & 3;
            transpose_item(p.w_up_m + (size_t)(64 * kb) * 1024 + 256 * t + 32 * lgrp(g), 1024, (bf16_t*)(ws + OFF_WUPM) + (size_t)(t * 256 + 32 * g) * 256 + 64 * kb, 256, scr, lane);
        } else {
            const int j = it - J5, t = j >> 7, rem = j & 127, g = rem >> 4, kb = rem & 15;
            transpose_item(p.w_out + (size_t)(64 * kb) * 1024 + 256 * t + 32 * lgrp(g), 1024, (bf16_t*)(ws + OFF_WOUT) + (size_t)(t * 256 + 32 * g) * 1024 + 64 * kb, 1024, scr, lane);
        }
    }
    rows_job(p.x_prompt, p.norm_in, (bf16_t*)(ws + OFF_H), T_P, 0, gw, NGW, lane);
    rows_job(p.x_sample, p.norm_in, (bf16_t*)(ws + OFF_H) + (size_t)T_P * 1024, 512, 0, gw, NGW, lane);
    rows_job(p.mem_prompt, p.g_mem, (bf16_t*)(ws + OFF_MEMH), 512, 512, gw, NGW, lane);
    if (tid < 128) {
        for (int j = tid * gridDim.x + blockIdx.x; j < 32768; j += 128 * gridDim.x) {
            const int prow = j >> 7, kc = j & 127;
            const int g = prow >> 5, l = 32 * lgrp(g) + (prow & 31);
            float w2[16];
#pragma unroll
            for (int r = 0; r < 16; ++r) w2[r] = p.w_gate2[r * 256 + l];
            float o[8];
#pragma unroll
            for (int kk = 0; kk < 8; ++kk) {
                const f32x4* wr4 = (const f32x4*)(p.w_in + (size_t)(8 * kc + kk) * 7184 + 3072);
                float sacc = 0.f;
#pragma unroll
                for (int q = 0; q < 4; ++q) { const f32x4 v = wr4[q]; sacc += v[0] * w2[4 * q] + v[1] * w2[4 * q + 1] + v[2] * w2[4 * q + 2] + v[3] * w2[4 * q + 3]; }
                o[kk] = sacc;
            }
            u32x4 w; w.x = pk2(o[0], o[1]); w.y = pk2(o[2], o[3]); w.z = pk2(o[4], o[5]); w.w = pk2(o[6], o[7]);
            *(u32x4*)((bf16_t*)(ws + OFF_WINT) + (size_t)(12 * 256 + prow) * 1024 + 8 * kc) = w;
        }
    }
}

DI void p0_caches(const Params& p, LAS unsigned char* lds, int rank, int nblk) {
    int tid = threadIdx.x; asm volatile("" : "+v"(tid));
    const int lane = tid & 63, wid = __builtin_amdgcn_readfirstlane(tid >> 6);
    const int gw = rank * 8 + wid, NGW = nblk * 8;
    unsigned char* ws = p.ws;
    LAS float* scr = (LAS float*)(lds + wid * 8448);
    for (int it = gw; it < 4096 + 1024; it += NGW) {
        if (it < 4096) {
            const int sb = it >> 7, rem = it & 127, ng = rem >> 3, kb = rem & 7;
            transpose_item(p.cache_a_v + (size_t)sb * 262144 + (size_t)(64 * kb) * 512 + 32 * ng, 512, (bf16_t*)(ws + OFF_VST) + (size_t)(sb * 512 + 32 * ng) * 528 + 64 * kb, 528, scr, lane);
        } else {
            const int j = it - 4096, sb = j >> 5, rem = j & 31, ng = rem >> 2, kb = rem & 3;
            transpose_item(p.cache_mem_v + (size_t)sb * 65536 + (size_t)(64 * kb) * 256 + 32 * ng, 256, (bf16_t*)(ws + OFF_MVST) + (size_t)(sb * 256 + 32 * ng) * 256 + 64 * kb, 256, scr, lane);
        }
    }
    const int gt = rank * 512 + tid, NGT = nblk * 512;
    for (int e0 = gt; e0 < 1048576; e0 += 4 * NGT) {
        f32x4 a[4][2];
#pragma unroll
        for (int q = 0; q < 4; ++q) { const int e = e0 + q * NGT; if (e < 1048576) { const f32x4* sp = (const f32x4*)(p.cache_a_k + (size_t)e * 8); a[q][0] = sp[0]; a[q][1] = sp[1]; } }
#pragma unroll
        for (int q = 0; q < 4; ++q) { const int e = e0 + q * NGT; if (e < 1048576) *(u32x4*)((bf16_t*)(ws + OFF_KS) + (size_t)(e >> 15) * 528 * 512 + (size_t)(e & 32767) * 8) = pack8(a[q][0], a[q][1]); }
    }
    for (int e0 = gt; e0 < 262144; e0 += 2 * NGT) {
        f32x4 a[2][2];
#pragma unroll
        for (int q = 0; q < 2; ++q) { const int e = e0 + q * NGT; if (e < 262144) { const f32x4* sp = (const f32x4*)(p.cache_mem_k + (size_t)e * 8); a[q][0] = sp[0]; a[q][1] = sp[1]; } }
#pragma unroll
        for (int q = 0; q < 2; ++q) { const int e = e0 + q * NGT; if (e < 262144) *(u32x4*)((bf16_t*)(ws + OFF_MKS) + (size_t)e * 8) = pack8(a[q][0], a[q][1]); }
    }
}

struct AttnItem { const bf16_t* q; int qld; int nq; const bf16_t* k; int kld; const bf16_t* vt; int vtld; int nkb; int nkeys; const LAS float* bias; int qpos0; bf16_t* zo; int zold; };

DI void attn_block(const AttnItem& it, int key0, int qi, int hh, const bf16x8 (&bq)[4], LAS unsigned char* Kl, LAS unsigned char* Vl, unsigned kr, unsigned vr,
                   float& mrun, float& lsum, f32x16& o0, f32x16& o1) {
    f32x16 s;
#pragma unroll
    for (int r = 0; r < 16; ++r) s[r] = 0.f;
#pragma unroll
    for (int kk = 0; kk < 4; ++kk) { const bf16x8 ak = *(const LAS bf16x8*)(Kl + kr + kk * 32); s = MFMA32(ak, bq[kk], s); }
    if (it.bias) {
        const int d0 = it.qpos0 - key0;
        if (d0 - 31 >= 128) {
            const float bc = it.bias[256];
#pragma unroll
            for (int r = 0; r < 16; ++r) s[r] += bc;
        } else {
#pragma unroll
            for (int r = 0; r < 16; ++r) {
                int d = d0 + qi - ((r & 3) + 8 * (r >> 2) + 4 * hh);
                d = d < -128 ? -128 : (d > 128 ? 128 : d);
                s[r] += it.bias[d + 128];
            }
        }
    }
    if (key0 + 32 > it.nkeys) {
#pragma unroll
        for (int r = 0; r < 16; ++r) if (key0 + (r & 3) + 8 * (r >> 2) + 4 * hh >= it.nkeys) s[r] = -1e30f;
    }
    float mx = s[0];
#pragma unroll
    for (int r = 1; r < 16; ++r) mx = fmaxf(mx, s[r]);
    mx = fmaxf(mx, __shfl_xor(mx, 32));
    const float mnew = fmaxf(mrun, mx);
    const float alpha = __builtin_amdgcn_exp2f(mrun - mnew);
    mrun = mnew;
    float rs = 0.f;
#pragma unroll
    for (int r = 0; r < 16; ++r) { s[r] = __builtin_amdgcn_exp2f(s[r] - mnew); rs += s[r]; }
    lsum = lsum * alpha + rs;
#pragma unroll
    for (int r = 0; r < 16; ++r) { o0[r] *= alpha; o1[r] *= alpha; }
#pragma unroll
    for (int ks = 0; ks < 2; ++ks) {
        u32x4 pw; pw.x = pk2(s[8 * ks], s[8 * ks + 1]); pw.y = pk2(s[8 * ks + 2], s[8 * ks + 3]); pw.z = pk2(s[8 * ks + 4], s[8 * ks + 5]); pw.w = pk2(s[8 * ks + 6], s[8 * ks + 7]);
        const bf16x8 pb = __builtin_bit_cast(bf16x8, pw);
        const u32x2 a00 = *(const LAS u32x2*)(Vl + vr + ks * 32), a01 = *(const LAS u32x2*)(Vl + vr + ks * 32 + 16);
        const u32x2 a10 = *(const LAS u32x2*)(Vl + vr + 2560 + ks * 32), a11 = *(const LAS u32x2*)(Vl + vr + 2560 + ks * 32 + 16);
        u32x4 a0; a0.x = a00.x; a0.y = a00.y; a0.z = a01.x; a0.w = a01.y;
        u32x4 a1; a1.x = a10.x; a1.y = a10.y; a1.z = a11.x; a1.w = a11.y;
        o0 = MFMA32(__builtin_bit_cast(bf16x8, a0), pb, o0);
        o1 = MFMA32(__builtin_bit_cast(bf16x8, a1), pb, o1);
    }
}

DI void attn_item(const AttnItem& it, LAS unsigned char* wl, int lane) {
    const int qi = lane & 31, hh = lane >> 5;
    const int qr = qi < it.nq ? qi : it.nq - 1;
    bf16x8 bq[4];
#pragma unroll
    for (int kk = 0; kk < 4; ++kk) bq[kk] = *(const bf16x8*)(it.q + (size_t)qr * it.qld + 16 * kk + 8 * hh);
    float mrun = -1e30f, lsum = 0.f;
    f32x16 o0, o1;
#pragma unroll
    for (int r = 0; r < 16; ++r) { o0[r] = 0.f; o1[r] = 0.f; }
    const int krow = lane >> 3, kch = lane & 7, vrow = lane >> 2, vch = lane & 3;
    const bf16_t* kg = it.k + (size_t)krow * it.kld + 8 * kch;
    const bf16_t* vg = it.vt + (size_t)vrow * it.vtld + 8 * vch;
    LAS unsigned char* Kl = wl; LAS unsigned char* Vl = wl + 4608;
    const unsigned kw = krow * 144 + kch * 16, vw = vrow * 80 + vch * 16;
    const unsigned kr = qi * 144 + hh * 16, vr = qi * 80 + hh * 8;
    u32x4 kA[4], vA[4], kB[4], vB[4];
#define ATT_LOAD(KR, VR, kb_) do { _Pragma("unroll") for (int i = 0; i < 4; ++i) { KR[i] = *(const u32x4*)(kg + (size_t)(32 * (kb_) + 8 * i) * it.kld); VR[i] = *(const u32x4*)(vg + (size_t)(16 * i) * it.vtld + 32 * (kb_)); } } while (0)
#define ATT_STORE(KR, VR) do { _Pragma("unroll") for (int i = 0; i < 4; ++i) { *(LAS u32x4*)(Kl + kw + i * 1152) = KR[i]; *(LAS u32x4*)(Vl + vw + i * 1280) = VR[i]; } } while (0)
    ATT_LOAD(kA, vA, 0);
    if (it.nkb > 1) ATT_LOAD(kB, vB, 1);
    for (int kb = 0; kb < it.nkb; kb += 2) {
        ATT_STORE(kA, vA);
        if (kb + 2 < it.nkb) ATT_LOAD(kA, vA, kb + 2);
        attn_block(it, 32 * kb, qi, hh, bq, Kl, Vl, kr, vr, mrun, lsum, o0, o1);
        if (kb + 1 < it.nkb) {
            ATT_STORE(kB, vB);
            if (kb + 3 < it.nkb) ATT_LOAD(kB, vB, kb + 3);
            attn_block(it, 32 * kb + 32, qi, hh, bq, Kl, Vl, kr, vr, mrun, lsum, o0, o1);
        }
    }
#undef ATT_LOAD
#undef ATT_STORE
    lsum += __shfl_xor(lsum, 32);
    const float inv = __fdividef(1.f, lsum);
    if (qi < it.nq) {
        bf16_t* zr = it.zo + (size_t)qi * it.zold + 4 * hh;
#pragma unroll
        for (int g = 0; g < 4; ++g) {
            { const u32x2 z = *(const u32x2*)(zr + 8 * g); u32x2 w;
              w.x = pk2(o0[4 * g] * inv * bflo(z.x), o0[4 * g + 1] * inv * bfhi(z.x)); w.y = pk2(o0[4 * g + 2] * inv * bflo(z.y), o0[4 * g + 3] * inv * bfhi(z.y));
              *(u32x2*)(zr + 8 * g) = w; }
            { const u32x2 z = *(const u32x2*)(zr + 32 + 8 * g); u32x2 w;
              w.x = pk2(o1[4 * g] * inv * bflo(z.x), o1[4 * g + 1] * inv * bfhi(z.x)); w.y = pk2(o1[4 * g + 2] * inv * bflo(z.y), o1[4 * g + 3] * inv * bfhi(z.y));
              *(u32x2*)(zr + 32 + 8 * g) = w; }
        }
    }
    LDS_WAIT();
}

DI void gla_local(const Params& p, int item, LAS unsigned char* wl, int lane) {
    unsigned char* ws = p.ws;
    const int c = item & 127, bh = item >> 7, h = bh & 3, b = bh >> 2;
    const int t0 = b * 8192 + 64 * c;
    const float* la = (const float*)(ws + OFF_LOGA) + (size_t)t0 * 256 + h * 64 + lane;
    const bf16_t* kb = (const bf16_t*)(ws + OFF_KB) + (size_t)t0 * 256 + h * 64 + lane;
    float lav[64]; bf16_t kvv[64];
#pragma unroll
    for (int t = 0; t < 64; ++t) { lav[t] = la[t * 256]; kvv[t] = kb[t * 256]; }
    __builtin_amdgcn_sched_barrier(0);
    float tot = 0.f;
#pragma unroll
    for (int t = 0; t < 64; ++t) tot += lav[t];
    float cum = 0.f;
#pragma unroll
    for (int t = 0; t < 64; ++t) {
        cum += lav[t];
        const float kh = bf2f(kvv[t]) * __expf(tot - cum);
        *(LAS bf16_t*)(wl + lane * 144 + 2 * t) = f2bf(kh);
    }
    ((float*)(ws + OFF_DEC))[item * 64 + lane] = __expf(tot);
    LDS_WAIT();
    const int qi = lane & 31, hh = lane >> 5;
    bf16x8 bk[2][4];
#pragma unroll
    for (int dkb = 0; dkb < 2; ++dkb)
#pragma unroll
        for (int ks = 0; ks < 4; ++ks) bk[dkb][ks] = *(const LAS bf16x8*)(wl + (32 * dkb + qi) * 144 + (16 * ks + 8 * hh) * 2);
    float* so = p.out + O_Y + (size_t)item * 8192;
#pragma unroll 1
    for (int dvb = 0; dvb < 4; ++dvb) {
        const bf16_t* vrow = (const bf16_t*)(ws + OFF_VBT) + (size_t)item * 8192 + (size_t)((dvb * 8 + hh) * 32 + qi) * 8;
        f32x16 a0, a1;
#pragma unroll
        for (int r = 0; r < 16; ++r) { a0[r] = 0.f; a1[r] = 0.f; }
        bf16x8 av[4];
#pragma unroll
        for (int ks = 0; ks < 4; ++ks) av[ks] = *(const bf16x8*)(vrow + 512 * ks);
        __builtin_amdgcn_sched_barrier(0);
#pragma unroll
        for (int ks = 0; ks < 4; ++ks) { a0 = MFMA32(av[ks], bk[0][ks], a0); a1 = MFMA32(av[ks], bk[1][ks], a1); }
#pragma unroll
        for (int r = 0; r < 16; ++r) { const int dv = 32 * dvb + (r & 3) + 8 * (r >> 2) + 4 * hh; so[dv * 64 + qi] = a0[r]; so[dv * 64 + 32 + qi] = a1[r]; }
    }
    LDS_WAIT();
}

template <bool SAMPLE>
DI void gla_out(const Params& p, int item, int tbsel, LAS unsigned char* wl, int lane) {
    unsigned char* ws = p.ws;
    int b = 0, h, c = 0, t0, sb = 0;
    if (SAMPLE) { sb = item >> 2; h = item & 3; t0 = T_P + 16 * sb; }
    else { c = item & 127; const int bh = item >> 7; h = bh & 3; b = bh >> 2; t0 = b * 8192 + 64 * c; }
    const float* la = (const float*)(ws + OFF_LOGA) + (size_t)t0 * 256 + h * 64 + lane;
    const bf16_t* qb = (const bf16_t*)(ws + OFF_QB) + (size_t)t0 * 256 + h * 64 + lane;
    const bf16_t* kb = (const bf16_t*)(ws + OFF_KB) + (size_t)t0 * 256 + h * 64 + lane;
    LAS unsigned char* Qs = wl; LAS unsigned char* Ks = wl + 9216;
    float cum = 0.f;
    constexpr int HB = SAMPLE ? 16 : 32;
    const int tb = SAMPLE ? 0 : tbsel;
    const int nhalf = SAMPLE ? 1 : tb + 1;
#pragma unroll 1
    for (int hf = 0; hf < nhalf; ++hf) {
        float lav[HB]; bf16_t qvv[HB], kvv[HB];
#pragma unroll
        for (int t = 0; t < HB; ++t) { lav[t] = la[(hf * 32 + t) * 256]; qvv[t] = qb[(hf * 32 + t) * 256]; kvv[t] = kb[(hf * 32 + t) * 256]; }
#pragma unroll
        for (int t = 0; t < HB; ++t) {
            cum += lav[t];
            const float qv = bf2f(qvv[t]) * __expf(cum), kv = bf2f(kvv[t]) * __expf(-cum);
            *(LAS bf16_t*)(Qs + (hf * 32 + t) * 144 + 2 * lane) = f2bf(qv);
            *(LAS bf16_t*)(Ks + (hf * 32 + t) * 144 + 2 * lane) = f2bf(kv);
        }
    }
    if (SAMPLE) {
#pragma unroll
        for (int t = 16; t < 32; ++t) { *(LAS bf16_t*)(Qs + t * 144 + 2 * lane) = 0; *(LAS bf16_t*)(Ks + t * 144 + 2 * lane) = 0; }
    }
    const float tot = cum;
    const int qi = lane & 31, hh = lane >> 5;
    bf16x8 sa[4][4]; u32x2 vf[2][2][4][2];
    if (!SAMPLE) {
#pragma unroll
        for (int dvb = 0; dvb < 4; ++dvb)
#pragma unroll
            for (int kk = 0; kk < 4; ++kk) sa[dvb][kk] = *(const bf16x8*)((const bf16_t*)(p.out + O_SPB) + (size_t)item * 8192 + (size_t)(((dvb * 4 + kk) * 2 + hh) * 32 + qi) * 8);
#pragma unroll
        for (int sbk = 0; sbk < 2; ++sbk) if (sbk <= tb) {
#pragma unroll
            for (int ks = 0; ks < 2; ++ks)
#pragma unroll
                for (int dvb = 0; dvb < 4; ++dvb) {
                    const bf16_t* vp = (const bf16_t*)(ws + OFF_VBT) + (size_t)item * 8192 + (size_t)((dvb * 8 + 4 * sbk + 2 * ks) * 32 + qi) * 8 + 4 * hh;
                    vf[sbk][ks][dvb][0] = *(const u32x2*)vp; vf[sbk][ks][dvb][1] = *(const u32x2*)(vp + 256);
                }
        }
        __builtin_amdgcn_sched_barrier(0);
    }
    LDS_WAIT();
    {
        bf16x8 bq[4];
#pragma unroll
        for (int kk = 0; kk < 4; ++kk) bq[kk] = *(const LAS bf16x8*)(Qs + (32 * tb + qi) * 144 + (16 * kk + 8 * hh) * 2);
        f32x16 o[4];
#pragma unroll
        for (int dvb = 0; dvb < 4; ++dvb)
#pragma unroll
            for (int r = 0; r < 16; ++r) o[dvb][r] = 0.f;
#pragma unroll
        for (int dvb = 0; dvb < 4; ++dvb)
#pragma unroll
            for (int kk = 0; kk < 4; ++kk) {
                bf16x8 a;
                if (!SAMPLE) {
                    a = sa[dvb][kk];
                } else {
                    const float* sp = p.state_gla + (size_t)item * 8192 + (size_t)(16 * kk + 8 * hh) * 128 + 32 * dvb + qi;
                    u32x4 w; w.x = pk2(sp[0], sp[128]); w.y = pk2(sp[256], sp[384]); w.z = pk2(sp[512], sp[640]); w.w = pk2(sp[768], sp[896]);
                    a = __builtin_bit_cast(bf16x8, w);
                }
                o[dvb] = MFMA32(a, bq[kk], o[dvb]);
                if (SAMPLE) asm volatile("" ::: "memory");
            }
#pragma unroll
        for (int sbk = 0; sbk < (SAMPLE ? 1 : 2); ++sbk) if (sbk <= tb) {
            f32x16 st;
#pragma unroll
            for (int r = 0; r < 16; ++r) st[r] = 0.f;
#pragma unroll
            for (int kk = 0; kk < 4; ++kk) { const bf16x8 ak = *(const LAS bf16x8*)(Ks + (32 * sbk + qi) * 144 + (16 * kk + 8 * hh) * 2); st = MFMA32(ak, bq[kk], st); }
            if (sbk == tb) {
#pragma unroll
                for (int r = 0; r < 16; ++r) if ((r & 3) + 8 * (r >> 2) + 4 * hh > qi) st[r] = 0.f;
            }
#pragma unroll
            for (int ks = 0; ks < (SAMPLE ? 1 : 2); ++ks) {
                u32x4 pw; pw.x = pk2(st[8 * ks], st[8 * ks + 1]); pw.y = pk2(st[8 * ks + 2], st[8 * ks + 3]); pw.z = pk2(st[8 * ks + 4], st[8 * ks + 5]); pw.w = pk2(st[8 * ks + 6], st[8 * ks + 7]);
                const bf16x8 pb = __builtin_bit_cast(bf16x8, pw);
#pragma unroll
                for (int dvb = 0; dvb < 4; ++dvb) {
                    u32x2 v0, v1;
                    if (SAMPLE) { const bf16_t* vp = (const bf16_t*)(ws + OFF_VBTS) + (size_t)(sb * 512 + h * 128 + 32 * dvb + qi) * 16 + 4 * hh; v0 = *(const u32x2*)vp; v1 = *(const u32x2*)(vp + 8); }
                    else { v0 = vf[sbk][ks][dvb][0]; v1 = vf[sbk][ks][dvb][1]; }
                    u32x4 aw; aw.x = v0.x; aw.y = v0.y; aw.z = v1.x; aw.w = v1.y;
                    o[dvb] = MFMA32(__builtin_bit_cast(bf16x8, aw), pb, o[dvb]);
                }
            }
        }
        float ss = 0.f;
#pragma unroll
        for (int dvb = 0; dvb < 4; ++dvb)
#pragma unroll
            for (int r = 0; r < 16; ++r) ss += o[dvb][r] * o[dvb][r];
        ss += __shfl_xor(ss, 32);
        const float rstd = rsqrtf(ss * (1.f / 128.f) + EPS);
        int lz = 0; asm volatile("" : "+v"(lz));
        if (!SAMPLE || qi < 16) {
            bf16_t* zr = (bf16_t*)(ws + OFF_ZB) + (size_t)(t0 + 32 * tb + qi) * 512 + h * 128 + 4 * hh;
#pragma unroll
            for (int dvb = 0; dvb < 4; ++dvb)
#pragma unroll
                for (int g = 0; g < 4; ++g) {
                    const int dv = 32 * dvb + 8 * g;
                    const f32x4 gg = *(const f32x4*)(p.g_gla_out + dv + 4 * hh + lz);
                    const u32x2 z = *(const u32x2*)(zr + dv); u32x2 w;
                    w.x = pk2(o[dvb][4 * g] * rstd * gg[0] * bflo(z.x), o[dvb][4 * g + 1] * rstd * gg[1] * bfhi(z.x));
                    w.y = pk2(o[dvb][4 * g + 2] * rstd * gg[2] * bflo(z.y), o[dvb][4 * g + 3] * rstd * gg[3] * bfhi(z.y));
                    *(u32x2*)(zr + dv) = w;
                }
        }
    }
    if (SAMPLE) {
        LDS_WAIT();
        float cum2 = 0.f;
#pragma unroll
        for (int t = 0; t < 16; ++t) {
            cum2 += la[t * 256];
            *(LAS bf16_t*)(Qs + lane * 144 + 2 * t) = f2bf(bf2f(kb[t * 256]) * __expf(tot - cum2));
        }
        ((LAS float*)Ks)[lane] = __expf(tot);
        LDS_WAIT();
#pragma unroll
        for (int dkb = 0; dkb < 2; ++dkb) {
            const bf16x8 ak = *(const LAS bf16x8*)(Qs + (32 * dkb + qi) * 144 + 8 * hh * 2);
#pragma unroll
            for (int dvb = 0; dvb < 4; ++dvb) {
                const bf16x8 bv = *(const bf16x8*)((const bf16_t*)(ws + OFF_VBTS) + (size_t)(sb * 512 + h * 128 + 32 * dvb + qi) * 16 + 8 * hh);
                f32x16 sl;
#pragma unroll
                for (int r = 0; r < 16; ++r) sl[r] = 0.f;
                sl = MFMA32(ak, bv, sl);
#pragma unroll
                for (int r = 0; r < 16; ++r) {
                    const int dk = 32 * dkb + (r & 3) + 8 * (r >> 2) + 4 * hh;
                    const size_t idx = (size_t)item * 8192 + (size_t)dk * 128 + 32 * dvb + qi;
                    p.out[O_GLS + idx] = p.state_gla[idx] * ((const LAS float*)Ks)[dk] + sl[r];
                }
            }
        }
    }
    LDS_WAIT();
}

DI void p2_mixers(const Params& p, LAS unsigned char* lds) {
    int tid = threadIdx.x; asm volatile("" : "+v"(tid));
    const int lane = tid & 63, wid = __builtin_amdgcn_readfirstlane(tid >> 6);
    unsigned char* ws = p.ws;
    LAS float* tab = (LAS float*)lds;
    for (int i = tid; i < 8 * 257; i += 512) tab[i] = p.rel_bias[i] * LOG2E;
    __syncthreads();
    LAS unsigned char* wl = lds + LDS_TAB + wid * LDS_WAVE;
    const int G = gridDim.x, gw = wid * G + blockIdx.x, NGW = G * 8;
    for (int it = gw, stage2 = 0;; it += NGW) {
        if (!stage2 && it >= 4096) { stage2 = 1; it = 4096 + gw; }
        if (stage2 && it >= 4352) break;
        AttnItem a;
        a.qld = 512; a.kld = 512; a.zold = 512;
        if (it < 4096) {
            const int head = it & 7, half = (it >> 3) & 1, c = (it >> 4) & 127, b = it >> 11;
            const int cs = c > 8 ? c - 8 : 0, kstart = 64 * cs, tq = b * 8192 + 64 * c + 32 * half;
            a.q = (const bf16_t*)(ws + OFF_QA) + (size_t)tq * 512 + head * 64; a.nq = 32;
            a.k = (const bf16_t*)(ws + OFF_KA) + (size_t)(b * 8192 + kstart) * 512 + head * 64;
            a.vt = (const bf16_t*)(ws + OFF_VAT) + (size_t)(b * 512 + head * 64) * VLD + kstart; a.vtld = VLD;
            a.nkeys = 64 * (c - cs + 1); a.nkb = a.nkeys >> 5;
            a.bias = tab + head * 257; a.qpos0 = 64 * c + 32 * half - kstart;
            a.zo = (bf16_t*)(ws + OFF_ZA) + (size_t)tq * 512 + head * 64;
        } else {
            const int j = it - 4096, head = j & 7, sb = j >> 3, tq = T_P + 16 * sb;
            a.q = (const bf16_t*)(ws + OFF_QA) + (size_t)tq * 512 + head * 64; a.nq = 16;
            a.k = (const bf16_t*)(ws + OFF_KS) + (size_t)sb * 528 * 512 + head * 64;
            a.vt = (const bf16_t*)(ws + OFF_VST) + (size_t)(sb * 512 + head * 64) * 528; a.vtld = 528;
            a.nkeys = 528; a.nkb = 17;
            a.bias = tab + head * 257; a.qpos0 = 512;
            a.zo = (bf16_t*)(ws + OFF_ZA) + (size_t)tq * 512 + head * 64;
        }
        attn_item(a, wl, lane);
    }
    {
        int m0 = -1, m1 = -1;
        if (NGW == 2048) { if (gw >= 256) m0 = gw - 256; if (gw >= 1536 && gw < 1792) m1 = gw + 256; if (gw >= 256 && gw < 384) m1 = 2048 + gw - 256; }
        for (int k = 0;; ++k) {
            int it;
            if (NGW == 2048) { if (k >= 2) break; it = k ? m1 : m0; if (it < 0) continue; }
            else { it = gw + k * NGW; if (it >= 2176) break; }
            AttnItem a;
            a.qld = 256; a.kld = 256; a.zold = 256; a.vtld = 256; a.nkeys = 256; a.nkb = 8; a.bias = nullptr; a.qpos0 = 0;
            if (it < 2048) {
                const int head = it & 3, tg = it >> 2, tq = 32 * tg, b = tq >> 13;
                a.q = (const bf16_t*)(ws + OFF_QM) + (size_t)tq * 256 + head * 64; a.nq = 32;
                a.k = (const bf16_t*)(ws + OFF_MK) + (size_t)b * 65536 + head * 64;
                a.vt = (const bf16_t*)(ws + OFF_MVT) + (size_t)(b * 256 + head * 64) * 256;
                a.zo = (bf16_t*)(ws + OFF_ZM) + (size_t)tq * 256 + head * 64;
            } else {
                const int j = it - 2048, head = j & 3, sb = j >> 2, tq = T_P + 16 * sb;
                a.q = (const bf16_t*)(ws + OFF_QM) + (size_t)tq * 256 + head * 64; a.nq = 16;
                a.k = (const bf16_t*)(ws + OFF_MKS) + (size_t)sb * 65536 + head * 64;
                a.vt = (const bf16_t*)(ws + OFF_MVST) + (size_t)(sb * 256 + head * 64) * 256;
                a.zo = (bf16_t*)(ws + OFF_ZM) + (size_t)tq * 256 + head * 64;
            }
            attn_item(a, wl, lane);
        }
    }
    { int s0 = gw - 384; if (s0 < 0) s0 += NGW; for (int it = s0; it < 1024; it += NGW) gla_local(p, ((it & 7) << 7) | (it >> 3), wl, lane); }
    { int s0 = gw - 1408; if (s0 < 0) s0 += NGW; for (int it = s0; it < 128; it += NGW) gla_out<true>(p, it, 0, wl, lane); }
}

DI int wt_row(int nb) { const int t = nb >> 3, q = nb & 7; return t * 256 + 128 * (q & 1) + 32 * (q >> 1); }
DI void sample_up_item(const Params& p, int item, int lane) {
    unsigned char* ws = p.ws;
    const int qi = lane & 31, hh = lane >> 5, tg = item >> 5, nb = item & 31;
    const int tok = T_P + 32 * tg + qi, wrow = wt_row(nb) + qi;
    f32x16 tot;
#pragma unroll
    for (int r = 0; r < 16; ++r) tot[r] = 0.f;
#pragma unroll
    for (int br = 0; br < 3; ++br) {
        const int ld = br == 2 ? 256 : 512;
        const bf16_t* gp = (const bf16_t*)(ws + (br == 0 ? OFF_ZA : (br == 1 ? OFF_ZB : OFF_ZM))) + (size_t)tok * ld + 8 * hh;
        const bf16_t* wp = (const bf16_t*)(ws + (br == 0 ? OFF_WUPA : (br == 1 ? OFF_WUPB : OFF_WUPM))) + (size_t)wrow * ld + 8 * hh;
        f32x16 acc;
#pragma unroll
        for (int r = 0; r < 16; ++r) acc[r] = 0.f;
#pragma unroll 1
        for (int c0 = 0; c0 < ld / 16; c0 += 16) {
            bf16x8 wa[16], ga[16];
#pragma unroll
            for (int j = 0; j < 16; ++j) { wa[j] = *(const bf16x8*)(wp + 16 * (c0 + j)); ga[j] = *(const bf16x8*)(gp + 16 * (c0 + j)); }
            __builtin_amdgcn_sched_barrier(0);
#pragma unroll
            for (int j = 0; j < 16; ++j) acc = MFMA32(wa[j], ga[j], acc);
            __builtin_amdgcn_sched_barrier(0);
        }
        const bf16_t* sg = (const bf16_t*)(ws + OFF_SGS) + (size_t)(tok - T_P) * 3072 + br * 1024 + 32 * nb + 4 * hh;
#pragma unroll
        for (int g = 0; g < 4; ++g) {
            const u32x2 z = *(const u32x2*)(sg + 8 * g);
            tot[4 * g] += acc[4 * g] * bflo(z.x); tot[4 * g + 1] += acc[4 * g + 1] * bfhi(z.x); tot[4 * g + 2] += acc[4 * g + 2] * bflo(z.y); tot[4 * g + 3] += acc[4 * g + 3] * bfhi(z.y);
        }
    }
    bf16_t* up = (bf16_t*)(ws + OFF_UB) + (size_t)tok * 1024 + 32 * nb + 4 * hh;
#pragma unroll
    for (int g = 0; g < 4; ++g) { u32x2 w; w.x = pk2(tot[4 * g], tot[4 * g + 1]); w.y = pk2(tot[4 * g + 2], tot[4 * g + 3]); *(u32x2*)(up + 8 * g) = w; }
}
DI void sample_out_item(const Params& p, int item, int lane) {
    unsigned char* ws = p.ws;
    const int qi = lane & 31, hh = lane >> 5, tg = item >> 5, nb = item & 31;
    const int tok = T_P + 32 * tg + qi, wrow = wt_row(nb) + qi;
    const bf16_t* up = (const bf16_t*)(ws + OFF_UB) + (size_t)tok * 1024 + 8 * hh;
    const bf16_t* wp = (const bf16_t*)(ws + OFF_WOUT) + (size_t)wrow * 1024 + 8 * hh;
    f32x16 acc;
#pragma unroll
    for (int r = 0; r < 16; ++r) acc[r] = 0.f;
#pragma unroll 1
    for (int c0 = 0; c0 < 64; c0 += 16) {
        bf16x8 wa[16], ga[16];
#pragma unroll
        for (int j = 0; j < 16; ++j) { wa[j] = *(const bf16x8*)(wp + 16 * (c0 + j)); ga[j] = *(const bf16x8*)(up + 16 * (c0 + j)); }
        __builtin_amdgcn_sched_barrier(0);
#pragma unroll
        for (int j = 0; j < 16; ++j) acc = MFMA32(wa[j], ga[j], acc);
        __builtin_amdgcn_sched_barrier(0);
    }
    const float* xr = p.x_sample + (size_t)(tok - T_P) * 1024 + 32 * nb + 4 * hh;
    float* yr = p.out + O_Y + (size_t)tok * 1024 + 32 * nb + 4 * hh;
#pragma unroll
    for (int g = 0; g < 4; ++g) { const f32x4 x = *(const f32x4*)(xr + 8 * g); f32x4 y; y[0] = x[0] + acc[4 * g]; y[1] = x[1] + acc[4 * g + 1]; y[2] = x[2] + acc[4 * g + 2]; y[3] = x[3] + acc[4 * g + 3]; *(f32x4*)(yr + 8 * g) = y; }
}

DI void p3_scan(const Params& p) {
    int tid = threadIdx.x; asm volatile("" : "+v"(tid));
    const int lane = tid & 63, wid = __builtin_amdgcn_readfirstlane(tid >> 6);
    const int G = gridDim.x, gw = wid * G + blockIdx.x, NGW = G * 8;
    const float* dec = (const float*)(p.ws + OFF_DEC);
    for (int w = gw; w < 1024; w += NGW) {
        const int bh = w & 7, idx = (w >> 3) * 64 + lane, dk = idx & 63, dv = idx >> 6;
        const float* sl = p.out + O_Y + (size_t)bh * 128 * 8192 + idx;
        bf16_t* sp = (bf16_t*)(p.out + O_SPB) + (size_t)bh * 128 * 8192 + (size_t)((((dv >> 5) * 4 + (dk >> 4)) * 2 + ((dk >> 3) & 1)) * 32 + (dv & 31)) * 8 + (dk & 7);
        const float* dc = dec + (size_t)bh * 128 * 64 + dk;
        float S = 0.f;
        for (int c0 = 0; c0 < 128; c0 += 32) {
            float v[32], d[32];
#pragma unroll
            for (int j = 0; j < 32; ++j) { v[j] = sl[(size_t)(c0 + j) * 8192]; d[j] = dc[(c0 + j) * 64]; }
            __builtin_amdgcn_sched_barrier(0);
#pragma unroll
            for (int j = 0; j < 32; ++j) { sp[(size_t)(c0 + j) * 8192] = f2bf(S); S = S * d[j] + v[j]; }
        }
        p.out[O_GLP + (size_t)bh * 8192 + dk * 128 + dv] = S;
    }
    { int s0 = gw - 1024; if (s0 < 0) s0 += NGW; for (int it = s0; it < 512; it += NGW) sample_up_item(p, it, lane); }
}

DI void p4_gla_out(const Params& p, LAS unsigned char* lds) {
    int tid = threadIdx.x; asm volatile("" : "+v"(tid));
    const int lane = tid & 63, wid = __builtin_amdgcn_readfirstlane(tid >> 6);
    LAS unsigned char* wl = lds + LDS_TAB + wid * LDS_WAVE;
    const int G = gridDim.x, gw = wid * G + blockIdx.x, NGW = G * 8;
    for (int it = gw; it < 2048; it += NGW) gla_out<false>(p, ((it & 7) << 7) | (it >> 4), (it >> 3) & 1, wl, lane);
    if (((gw >> 3) & 1) == 0) for (int it = ((gw >> 4) << 3) | (gw & 7); it < 512; it += NGW >> 1) sample_out_item(p, it, lane);
}

#define XB_TMO      128
#define XB_XCNT(j)  (256  + 64 * (j))
#define XB_XSUB(j)  (1280 + 64 * (j))
#define XB_XGEN(j)  (2304 + 64 * (j))
#define XB_TOP      3328
#define XB_TOPGEN   3392
#define XCD_BAR_WORDS 3456
#define XB_SPIN_CAP (1u << 18)
DI unsigned xb_ld(unsigned* p)              { return __hip_atomic_load(p, __ATOMIC_RELAXED, __HIP_MEMORY_SCOPE_AGENT); }
DI unsigned xb_add(unsigned* p, unsigned v) { return __hip_atomic_fetch_add(p, v, __ATOMIC_RELAXED, __HIP_MEMORY_SCOPE_AGENT); }
DI unsigned xb_xcc_id() { return (unsigned)__builtin_amdgcn_s_getreg((3 << 11) | 20) & 0xFu; }
#define XB_SPIN(cond, bar) do { unsigned _sp = 0; while (cond) { __builtin_amdgcn_s_sleep(1); \
    if ((++_sp & 255u) == 0u) { if (xb_ld(&(bar)[XB_TMO])) break; if (_sp > XB_SPIN_CAP) { atomicAdd(&(bar)[XB_TMO], 1u); break; } } } } while (0)
struct XcdBarrier { unsigned* bar; unsigned x; volatile LAS unsigned* st; };
DI XcdBarrier xcd_barrier_post(unsigned* bar, volatile LAS unsigned* st) {
    XcdBarrier b; b.bar = bar; b.x = xb_xcc_id(); b.st = st;
    if (threadIdx.x == 0) (void)xb_add(&bar[XB_XCNT(b.x)], 1u);
    return b;
}
DI void xcd_barrier_complete(unsigned* bar, unsigned x, unsigned& nloc, unsigned& nx) {
    const unsigned G = gridDim.x * gridDim.y * gridDim.z;
    unsigned sum, cnt, mine, sp = 0u;
    for (;;) {
        sum = 0u; cnt = 0u; mine = 0u;
#pragma unroll
        for (unsigned j = 0; j < 16; ++j) { const unsigned c = xb_ld(&bar[XB_XCNT(j)]); sum += c; cnt += (c > 0u) ? 1u : 0u; mine = (j == x) ? c : mine; }
        if (sum == G) break;
        __builtin_amdgcn_s_sleep(1);
        if ((++sp & 255u) == 0u) { if (xb_ld(&bar[XB_TMO])) break; if (sp > XB_SPIN_CAP) { atomicAdd(&bar[XB_TMO], 1u); break; } }
    }
    nloc = mine > 0u ? mine : 1u; nx = cnt > 0u ? cnt : 1u;
}
DI void xcd_barrier(const XcdBarrier& b) {
    asm volatile("s_waitcnt vmcnt(0)" ::: "memory");
    __syncthreads();
    if (threadIdx.x == 0) {
        unsigned* bar = b.bar;
        __builtin_amdgcn_s_waitcnt(0);
        unsigned nloc = b.st[0], nx = b.st[1];
        if (nloc == 0u) { xcd_barrier_complete(bar, b.x, nloc, nx); b.st[0] = nloc; b.st[1] = nx; }
        const unsigned old = xb_add(&bar[XB_XSUB(b.x)], 1u);
        const unsigned gen = old / nloc;
        if (old + 1u == (gen + 1u) * nloc) {
            __builtin_amdgcn_fence(__ATOMIC_RELEASE, "agent");
            asm volatile("s_waitcnt vmcnt(0)" ::: "memory");
            const unsigned og = xb_add(&bar[XB_TOP], 1u);
            const unsigned tg = og / nx;
            if (og + 1u == (tg + 1u) * nx) xb_add(&bar[XB_TOPGEN], 1u);
            else XB_SPIN(xb_ld(&bar[XB_TOPGEN]) == tg, bar);
            __builtin_amdgcn_fence(__ATOMIC_ACQUIRE, "agent");
            xb_add(&bar[XB_XGEN(b.x)], 1u);
            asm volatile("s_waitcnt vmcnt(0)" ::: "memory");
        } else {
            XB_SPIN(xb_ld(&bar[XB_XGEN(b.x)]) == gen, bar);
            __builtin_amdgcn_fence(__ATOMIC_ACQUIRE, "agent");
            asm volatile("s_waitcnt vmcnt(0)" ::: "memory");
        }
    }
    __syncthreads();
}

__global__ void __launch_bounds__(512, 2) fwd_megakernel(Params p) {
    extern __shared__ __attribute__((aligned(16))) unsigned char lds_raw[];
    LAS unsigned char* lds = (LAS unsigned char*)lds_raw;
    if (threadIdx.x < 4) ((volatile LAS unsigned*)(lds + LDS_BAR))[threadIdx.x] = 0u;
    __syncthreads();
    const XcdBarrier bar = xcd_barrier_post((unsigned*)(p.ws + OFF_BAR), (volatile LAS unsigned*)(lds + LDS_BAR));
    if (p.ws == nullptr) cg::this_grid().sync();
    p0_prep(p, lds);
    xcd_barrier(bar);
    gemm_phase<1>(p, lds, 0);
    { const int nfull = (66 * 17 + 4 + 24) % (int)gridDim.x, nslack = (int)gridDim.x - nfull;
      if (nslack >= 32) { if ((int)blockIdx.x >= nfull) p0_caches(p, lds, (int)blockIdx.x - nfull, nslack); } else p0_caches(p, lds, (int)blockIdx.x, (int)gridDim.x); }
    xcd_barrier(bar);
    p2_mixers(p, lds);
    xcd_barrier(bar);
    p3_scan(p);
    xcd_barrier(bar);
    p4_gla_out(p, lds);
    xcd_barrier(bar);
    gemm_phase<5>(p, lds, 0);
    xcd_barrier(bar);
    gemm_phase<6>(p, lds, 0);
}

extern "C" void kernel_launch(void* const* d_in, const int* in_sizes, int n_in, void* d_out, int out_size, void* d_ws, size_t ws_size, hipStream_t stream) {
    static int grid_blocks = 0;
    if (grid_blocks == 0) {
        if (n_in != 24 || out_size != 20250624 || ws_size < WS_END) { fprintf(stderr, "kernel_launch: unexpected shapes (n_in %d out %d ws %zu)\n", n_in, out_size, ws_size); grid_blocks = -1; return; }
        int dev = 0, cus = 0, per_cu = 0;
        hipGetDevice(&dev);
        hipDeviceGetAttribute(&cus, hipDeviceAttributeMultiprocessorCount, dev);
        if (hipFuncSetAttribute((const void*)fwd_megakernel, hipFuncAttributeMaxDynamicSharedMemorySize, LDS_BYTES) != hipSuccess) { fprintf(stderr, "kernel_launch: hipFuncSetAttribute failed\n"); grid_blocks = -1; return; }
        if (hipOccupancyMaxActiveBlocksPerMultiprocessor(&per_cu, (const void*)fwd_megakernel, 512, LDS_BYTES) != hipSuccess || per_cu < 1) { fprintf(stderr, "kernel_launch: occupancy query failed (%d)\n", per_cu); (void)hipGetLastError(); grid_blocks = -1; return; }
        grid_blocks = cus * per_cu;
        if (grid_blocks > 256) grid_blocks = 256;
        if (grid_blocks < 16) { fprintf(stderr, "kernel_launch: grid of %d workgroups is too small for this kernel\n", grid_blocks); grid_blocks = -1; return; }
    }
    if (grid_blocks < 0) return;
    if (hipMemsetAsync((char*)d_ws + OFF_BAR, 0, 16384, stream) != hipSuccess) { fprintf(stderr, "kernel_launch: hipMemsetAsync failed\n"); return; }
    Params p{};
    const float** pp = (const float**)&p;
    for (int i = 0; i < 24; ++i) pp[i] = (const float*)d_in[i];
    p.out = (float*)d_out; p.ws = (unsigned char*)d_ws;
    void* args[] = {&p};
    hipError_t e = hipLaunchCooperativeKernel((const void*)fwd_megakernel, dim3(grid_blocks), dim3(512), args, LDS_BYTES, stream);
    if (e != hipSuccess) fprintf(stderr, "cooperative launch failed: %s (grid %d)\n", hipGetErrorString(e), grid_blocks);
}
```
